# Optimizing an MI355X kernel written in HIP

```python
import jax, jax.numpy as jnp
from jax import lax
import numpy as np

D_MODEL = 1024
BATCH = 8
SEQ = 2048
DEPTH = 1

CHUNK = 64
HEAD_DIM = 64
H_SB = 8
H_CH = 8
W_SB = H_SB * HEAD_DIM
W_CH = H_CH * HEAD_DIM
MIX_WIDTH = W_SB + W_CH
LOOKBACK = 8
BAND = (LOOKBACK + 1) * CHUNK
REL_CLIP = 128
Q_BLOCK = 128
D_FF = 2816
PLE_DIM = 256
EPS = 1e-6
NEG_INF = -1e30

kernel_name = "hybrid_stickbreak_chunkattn_macaron_block"


def rms_norm(x, g):
    xf = x.astype(jnp.float32)
    y = xf * lax.rsqrt(jnp.mean(xf * xf, axis=-1, keepdims=True) + EPS)
    return (y * g.astype(jnp.float32)).astype(x.dtype)


def swiglu(x, w_gate, w_up, w_down):
    return (jax.nn.silu(x @ w_gate) * (x @ w_up)) @ w_down


def split_heads(t, n_heads):
    b, s, _ = t.shape
    return t.reshape(b, s, n_heads, HEAD_DIM).transpose(0, 2, 1, 3)


def merge_heads(t):
    b, h, s, d = t.shape
    return t.transpose(0, 2, 1, 3).reshape(b, s, h * d)


def stick_breaking_attention(q, k, v):
    b, h, s, d = q.shape
    nq = s // Q_BLOCK
    scale = d ** -0.5
    q_blocks = q.reshape(b, h, nq, Q_BLOCK, d).transpose(2, 0, 1, 3, 4)
    starts = jnp.arange(nq, dtype=jnp.int32) * Q_BLOCK
    key_pos = jnp.arange(s, dtype=jnp.int32)

    def one_block(args):
        q_blk, start = args
        z = jnp.einsum('bhqd,bhkd->bhqk', q_blk, k,
                       preferred_element_type=jnp.float32) * scale
        q_pos = start + jnp.arange(Q_BLOCK, dtype=jnp.int32)
        before = key_pos[None, :] < q_pos[:, None]
        log_fail = jnp.where(before, jax.nn.log_sigmoid(-z), 0.0)
        later = lax.cumsum(log_fail, axis=3, reverse=True) - log_fail
        log_a = jax.nn.log_sigmoid(z) + later
        a = jnp.where(before, jnp.exp(jnp.where(before, log_a, 0.0)), 0.0)
        return jnp.einsum('bhqk,bhkd->bhqd', a.astype(v.dtype), v)

    out = lax.map(one_block, (q_blocks, starts))
    return out.transpose(1, 2, 0, 3, 4).reshape(b, h, s, d)


def rel_bias_index():
    i = np.arange(CHUNK)[:, None]
    j = np.arange(BAND)[None, :]
    dist = i + LOOKBACK * CHUNK - j
    return jnp.asarray(np.clip(dist, -REL_CLIP, REL_CLIP) + REL_CLIP, dtype=jnp.int32)


def chunk_band_attention(q, k, v, rel_bias):
    b, h, s, d = q.shape
    nc = s // CHUNK
    scale = d ** -0.5
    qc = q.reshape(b, h, nc, CHUNK, d)

    def band(t):
        tc = t.reshape(b, h, nc, CHUNK, d)
        tp = jnp.pad(tc, ((0, 0), (0, 0), (LOOKBACK, 0), (0, 0), (0, 0)))
        return jnp.concatenate([tp[:, :, w:w + nc] for w in range(LOOKBACK + 1)], axis=3)

    kb, vb = band(k), band(v)
    bias = rel_bias.astype(jnp.float32)[:, rel_bias_index()]
    z = jnp.einsum('bhnqd,bhnkd->bhnqk', qc, kb,
                   preferred_element_type=jnp.float32) * scale + bias[None, :, None]
    slot_chunk = jnp.arange(BAND, dtype=jnp.int32) // CHUNK
    chunk_id = jnp.arange(nc, dtype=jnp.int32)
    valid = (chunk_id[:, None] + slot_chunk[None, :] - LOOKBACK) >= 0
    z = jnp.where(valid[None, None, :, None, :], z, NEG_INF)
    prob = jax.nn.softmax(z, axis=-1)
    o = jnp.einsum('bhnqk,bhnkd->bhnqd', prob.astype(vb.dtype), vb)
    return o.reshape(b, h, s, d)


def setup_inputs(seed: int = 0) -> dict:
    key = jax.random.key(seed)
    ks = jax.random.split(key, 24)
    f32 = jnp.float32

    def w(k, shape, fan_in):
        return jax.random.normal(k, shape, f32) * (fan_in ** -0.5)

    def gain(k, n):
        return 1.0 + 0.05 * jax.random.normal(k, (DEPTH, n), f32)

    return {
        "x": jax.random.normal(ks[0], (BATCH, SEQ, D_MODEL), f32),
        "p": jax.random.normal(ks[1], (DEPTH, BATCH, SEQ, PLE_DIM), f32),
        "g_ffn1_pre": gain(ks[2], D_MODEL),
        "g_ffn1_post": gain(ks[3], D_MODEL),
        "w_ffn1_gate": w(ks[4], (DEPTH, D_MODEL, D_FF), D_MODEL),
        "w_ffn1_up": w(ks[5], (DEPTH, D_MODEL, D_FF), D_MODEL),
        "w_ffn1_down": w(ks[6], (DEPTH, D_FF, D_MODEL), D_FF),
        "g_mix_pre": gain(ks[7], D_MODEL),
        "g_mix_post": gain(ks[8], D_MODEL),
        "w_in": w(ks[9], (DEPTH, D_MODEL, 3 * MIX_WIDTH), D_MODEL),
        "g_out_sb": gain(ks[10], W_SB),
        "g_out_ch": gain(ks[11], W_CH),
        "rel_bias": 0.02 * jax.random.normal(ks[12], (DEPTH, H_CH, 2 * REL_CLIP + 1), f32),
        "w_out": w(ks[13], (DEPTH, MIX_WIDTH, D_MODEL), MIX_WIDTH),
        "g_ffn2_pre": gain(ks[14], D_MODEL),
        "g_ffn2_post": gain(ks[15], D_MODEL),
        "w_ffn2_gate": w(ks[16], (DEPTH, D_MODEL, D_FF), D_MODEL),
        "w_ffn2_up": w(ks[17], (DEPTH, D_MODEL, D_FF), D_MODEL),
        "w_ffn2_down": w(ks[18], (DEPTH, D_FF, D_MODEL), D_FF),
        "w_ple_proj": w(ks[19], (DEPTH, PLE_DIM, D_MODEL), PLE_DIM),
        "w_ple_gate": w(ks[20], (DEPTH, D_MODEL, D_MODEL), D_MODEL),
        "g_ple_post": gain(ks[21], D_MODEL),
    }


def reference(x, p, g_ffn1_pre, g_ffn1_post, w_ffn1_gate, w_ffn1_up, w_ffn1_down,
              g_mix_pre, g_mix_post, w_in, g_out_sb, g_out_ch, rel_bias, w_out,
              g_ffn2_pre, g_ffn2_post, w_ffn2_gate, w_ffn2_up, w_ffn2_down,
              w_ple_proj, w_ple_gate, g_ple_post):
    h = x
    for i in range(DEPTH):
        f = swiglu(rms_norm(h, g_ffn1_pre[i]), w_ffn1_gate[i], w_ffn1_up[i], w_ffn1_down[i])
        h = h + 0.5 * rms_norm(f, g_ffn1_post[i])

        u = rms_norm(h, g_mix_pre[i])
        qkv = u @ w_in[i]
        q_a, k_a, v_a, q_b, k_b, v_b = jnp.split(
            qkv, np.cumsum([W_SB, W_SB, W_SB, W_CH, W_CH])[:5].tolist(), axis=-1)
        o_a = stick_breaking_attention(split_heads(q_a, H_SB), split_heads(k_a, H_SB),
                                       split_heads(v_a, H_SB))
        o_b = chunk_band_attention(split_heads(q_b, H_CH), split_heads(k_b, H_CH),
                                   split_heads(v_b, H_CH), rel_bias[i])
        mixed = jnp.concatenate([rms_norm(merge_heads(o_a), g_out_sb[i]),
                                 rms_norm(merge_heads(o_b), g_out_ch[i])], axis=-1)
        h = h + rms_norm(mixed @ w_out[i], g_mix_post[i])

        f = swiglu(rms_norm(h, g_ffn2_pre[i]), w_ffn2_gate[i], w_ffn2_up[i], w_ffn2_down[i])
        h = h + 0.5 * rms_norm(f, g_ffn2_post[i])

        e = (p[i] @ w_ple_proj[i]) * jax.nn.sigmoid(h @ w_ple_gate[i])
        h = h + rms_norm(e, g_ple_post[i])
    return h
```

```cpp
#include <hip/hip_runtime.h>
#include <cstdio>
#include <cstdint>
namespace pg8 {
#define PG8_LAS __attribute__((address_space(3)))
typedef unsigned short bf16_t;
typedef short bf16x8 __attribute__((ext_vector_type(8)));
typedef float f32x4 __attribute__((ext_vector_type(4)));
typedef unsigned u32x4 __attribute__((ext_vector_type(4)));
constexpr int BM = 256, BK = 64, HALF = 128, HTB = HALF * BK * 2  , STAGE_BYTES = 8 * HTB, NXCD = 8, WGM = 8;

__host__ __device__ __forceinline__ int lds_byte(int r, int c) { const int st = (r >> 4) * 2 + (c >> 5), rr = r & 15, cc = c & 31, ob = rr * 64 + cc * 2; return st * 1024 + (ob ^ (((ob >> 9) & 1) << 5)); }
__host__ __device__ __forceinline__ void stage_rc(int b, int& R, int& C) { const int st = b / 1024, sb = b % 1024, swz = sb ^ (((sb >> 9) & 1) << 5); R = (st >> 1) * 16 + swz / 64; C = (st & 1) * 32 + (swz % 64) / 2; }
__host__ __device__ __forceinline__ int perm32(int rho) { const int n = rho >> 4, i = rho & 15; return 8 * (i >> 2) + 4 * n + (i & 3); }

struct Unit { int pm, pn; };
struct Gemm { const bf16_t* A; const bf16_t* Bt; int M, N, K; };

struct StaticOrder {
    int nM, nN, nwg, G, c;
    __host__ __device__ void init(int M, int N, int G_, int c_) { nM = M / BM; nN = N / BM; nwg = nM * nN; G = G_; c = c_; }
    __host__ __device__ bool next(int i, Unit& u) const {
        const long L = (long)i * G + c; if (L >= nwg) return false;
        int wgid = (int)L; { const int q = nwg / NXCD, r = nwg % NXCD, xcd = wgid % NXCD, off = wgid / NXCD; wgid = (xcd < r ? xcd * (q + 1) : r * (q + 1) + (xcd - r) * q) + off; }
        const int nig = WGM * nN, gid = wgid / nig, fm = gid * WGM, gsz = (nM - fm) < WGM ? (nM - fm) : WGM;
        u.pm = fm + ((wgid % nig) % gsz); u.pn = (wgid % nig) / gsz; return true;
    }
    __device__ __forceinline__ void a_ready(const Unit&) const {}
    __device__ __forceinline__ void done(const Unit&) const {}
};

__device__ __forceinline__ unsigned cvt_pk_bf16(float lo, float hi) { unsigned r; asm volatile("v_cvt_pk_bf16_f32 %0, %1, %2" : "=v"(r) : "v"(lo), "v"(hi)); return r; }

struct EpiF32 {
    static constexpr bool PERM = false, AFTER_DRAIN = false;
    float* F; int ldc;
    __device__ __forceinline__ void operator()(const f32x4 (&acc)[2][2][4][2], const Unit& u, int wr, int wc, int fr, int fq) const {
        const int row0 = u.pm * BM + wr * 64 + fr, col0 = u.pn * BM + wc * 32 + 4 * fq;
#pragma unroll
        for (int ai = 0; ai < 2; ++ai)
#pragma unroll
            for (int m = 0; m < 4; ++m) { float* rowp = F + (size_t)(row0 + ai * HALF + m * 16) * ldc + col0;
#pragma unroll
                for (int bj = 0; bj < 2; ++bj)
#pragma unroll
                    for (int n = 0; n < 2; ++n) *(f32x4*)(rowp + bj * HALF + n * 16) = acc[ai][bj][m][n]; }
    }
};
struct EpiBf16 {
    static constexpr bool PERM = true, AFTER_DRAIN = false;
    bf16_t* O; int ldc;
    __device__ __forceinline__ void operator()(const f32x4 (&acc)[2][2][4][2], const Unit& u, int wr, int wc, int fr, int fq) const {
        const int row0 = u.pm * BM + wr * 64 + fr, col0 = u.pn * BM + wc * 32 + 8 * fq;
#pragma unroll
        for (int ai = 0; ai < 2; ++ai)
#pragma unroll
            for (int m = 0; m < 4; ++m) { bf16_t* rowp = O + (size_t)(row0 + ai * HALF + m * 16) * ldc + col0;
#pragma unroll
                for (int bj = 0; bj < 2; ++bj) { const f32x4 v0 = acc[ai][bj][m][0], v1 = acc[ai][bj][m][1];
                    u32x4 w; w.x = cvt_pk_bf16(v0[0], v0[1]); w.y = cvt_pk_bf16(v0[2], v0[3]); w.z = cvt_pk_bf16(v1[0], v1[1]); w.w = cvt_pk_bf16(v1[2], v1[3]);
                    *(u32x4*)(rowp + bj * HALF) = w; } }
    }
};
__device__ __forceinline__ float silu_mul(float g, float u) { return g * u * __builtin_amdgcn_rcpf(1.0f + __expf(-g)); }
struct EpiSwiGLU {
    static constexpr bool PERM = true, AFTER_DRAIN = false;
    bf16_t* H; int ldh;
    __device__ __forceinline__ void operator()(const f32x4 (&acc)[2][2][4][2], const Unit& u, int wr, int wc, int fr, int fq) const {
        const int row0 = u.pm * BM + wr * 64 + fr, col0 = u.pn * HALF + wc * 32 + 8 * fq;
#pragma unroll
        for (int ai = 0; ai < 2; ++ai)
#pragma unroll
            for (int m = 0; m < 4; ++m) { bf16_t* rowp = H + (size_t)(row0 + ai * HALF + m * 16) * ldh + col0;
                const f32x4 g0 = acc[ai][0][m][0], g1 = acc[ai][0][m][1], u0 = acc[ai][1][m][0], u1 = acc[ai][1][m][1];
                u32x4 w; w.x = cvt_pk_bf16(silu_mul(g0[0], u0[0]), silu_mul(g0[1], u0[1])); w.y = cvt_pk_bf16(silu_mul(g0[2], u0[2]), silu_mul(g0[3], u0[3]));
                w.z = cvt_pk_bf16(silu_mul(g1[0], u1[0]), silu_mul(g1[1], u1[1])); w.w = cvt_pk_bf16(silu_mul(g1[2], u1[2]), silu_mul(g1[3], u1[3]));
                *(u32x4*)rowp = w; }
    }
};

template <class Epi, class Sched, bool ALIGN_EPI = false, bool SP2 = false>
__device__ __forceinline__ void gemm_phase(PG8_LAS unsigned char* lds, const Gemm g, const Sched& S, const Epi& E) {
    const int tid = threadIdx.x, wid = __builtin_amdgcn_readfirstlane(tid >> 6), lane = tid & 63, wr = wid >> 2, wc = wid & 3, fr = lane & 15, fq = lane >> 4;
    const int K = g.K, nt = K / BK;
    unsigned voffA[2], voffB[2];
#pragma unroll
    for (int i = 0; i < 2; ++i) { int R, C; stage_rc(tid * 16 + i * 8192, R, C); const int Rb = Epi::PERM ? ((R & ~31) + perm32(R & 31)) : R;
        voffA[i] = (unsigned)(R * K + C) * 2u; voffB[i] = (unsigned)(Rb * K + C) * 2u; }
    const size_t kstep = (size_t)(BK * 2);
    const size_t hstep = (size_t)HALF * K * 2;
    const size_t tstep = 2 * hstep;
    const unsigned ldsw = (unsigned)wid * 1024u;
    const int aoff = lds_byte(wr * 64 + fr, fq * 8), boff = lds_byte(wc * 32 + fr, fq * 8);
#define PG8_SA(b, h) (((b) * 2 + (h)) * HTB)
#define PG8_SB(b, h) ((4 + (b) * 2 + (h)) * HTB)
#define PG8_STAGE(bufoff, gbase, voff) do { _Pragma("unroll") for (int _i = 0; _i < 2; ++_i) \
        __builtin_amdgcn_global_load_lds((const unsigned*)((const char*)(gbase) + (voff)[_i]), (PG8_LAS unsigned*)(lds + (bufoff) + ldsw + _i * 8192), 16, 0, 0); } while (0)
#define PG8_LDA(dst, b, h) do { _Pragma("unroll") for (int m = 0; m < 4; ++m) _Pragma("unroll") for (int k = 0; k < 2; ++k) dst[m][k] = *(const PG8_LAS bf16x8*)(lds + PG8_SA(b, h) + aoff + m * 2048 + k * 1024); } while (0)
#define PG8_LDB(dst, b, h) do { _Pragma("unroll") for (int n = 0; n < 2; ++n) _Pragma("unroll") for (int k = 0; k < 2; ++k) dst[n][k] = *(const PG8_LAS bf16x8*)(lds + PG8_SB(b, h) + boff + n * 2048 + k * 1024); } while (0)
#define PG8_MMA(ai, bj, At, Bt) do { __builtin_amdgcn_s_setprio(1); _Pragma("unroll") for (int m = 0; m < 4; ++m) _Pragma("unroll") for (int n = 0; n < 2; ++n) _Pragma("unroll") for (int k = 0; k < 2; ++k) \
        acc[ai][bj][m][n] = __builtin_amdgcn_mfma_f32_16x16x32_bf16(Bt[n][k], At[m][k], acc[ai][bj][m][n], 0, 0, 0); __builtin_amdgcn_s_setprio(0); } while (0)
#define PG8_WAIT_V(n) asm volatile("s_waitcnt vmcnt(" #n ")" ::: "memory")
#define PG8_WAIT_L(n) asm volatile("s_waitcnt lgkmcnt(" #n ")" ::: "memory")
#define PG8_BAR __builtin_amdgcn_s_barrier()
#define PG8_SCHED __builtin_amdgcn_sched_barrier(0)
    Unit cur, nxt; int ui = 0;
    if (!S.next(0, cur)) return;
    f32x4 acc[2][2][4][2];
#pragma unroll
    for (int a = 0; a < 2; ++a)
#pragma unroll
        for (int b = 0; b < 2; ++b)
#pragma unroll
            for (int m = 0; m < 4; ++m)
#pragma unroll
                for (int n = 0; n < 2; ++n) acc[a][b][m][n] = (f32x4){0.f, 0.f, 0.f, 0.f};
    bf16x8 At[4][2], B0[2][2], B1[2][2];
    const char* cA = (const char*)g.A + (size_t)cur.pm * tstep; const char* cB = (const char*)g.Bt + (size_t)cur.pn * tstep;
    S.a_ready(cur);
    if constexpr (SP2) {
        PG8_STAGE(PG8_SB(0, 0), cB, voffB); PG8_STAGE(PG8_SB(0, 1), cB + hstep, voffB); PG8_STAGE(PG8_SA(0, 0), cA, voffA); PG8_STAGE(PG8_SA(0, 1), cA + hstep, voffA);
        if (wr == 1) PG8_BAR;
        PG8_WAIT_V(2); PG8_BAR;
        PG8_STAGE(PG8_SB(1, 0), cB + kstep, voffB); PG8_STAGE(PG8_SA(1, 0), cA + kstep, voffA); PG8_STAGE(PG8_SB(1, 1), cB + hstep + kstep, voffB);
        PG8_WAIT_V(6); PG8_BAR;
    } else {
        PG8_STAGE(PG8_SB(0, 0), cB, voffB); PG8_STAGE(PG8_SA(0, 0), cA, voffA); PG8_STAGE(PG8_SB(0, 1), cB + hstep, voffB); PG8_STAGE(PG8_SA(0, 1), cA + hstep, voffA);
        if (wr == 1) PG8_BAR;
        PG8_WAIT_V(4); PG8_BAR;
        PG8_STAGE(PG8_SB(1, 0), cB + kstep, voffB); PG8_STAGE(PG8_SA(1, 0), cA + kstep, voffA); PG8_STAGE(PG8_SB(1, 1), cB + hstep + kstep, voffB);
        PG8_WAIT_V(6); PG8_BAR;
    }
    for (;;) {
        const bool has_next = S.next(ui + 1, nxt);
        const char* nA = has_next ? (const char*)g.A + (size_t)nxt.pm * tstep : cA; const char* nB = has_next ? (const char*)g.Bt + (size_t)nxt.pn * tstep : cB;
        for (int t = 0; t < nt; t += 2) {
            const bool last = (t == nt - 2);
            const char* a1 = cA + (size_t)(t + 1) * kstep;
            const char* a2 = last ? nA : cA + (size_t)(t + 2) * kstep; const char* b2 = last ? nB : cB + (size_t)(t + 2) * kstep;
            const char* a3 = a2 + kstep; const char* b3 = b2 + kstep;
            if (last && has_next) S.a_ready(nxt);
            if constexpr (SP2) {
            PG8_LDB(B0, 0, 0); PG8_LDB(B1, 0, 1); PG8_SCHED; PG8_LDA(At, 0, 0); PG8_STAGE(PG8_SA(1, 1), a1 + hstep, voffA);
            PG8_WAIT_V(8); PG8_WAIT_L(0); PG8_BAR; PG8_MMA(0, 0, At, B0); PG8_MMA(0, 1, At, B1); PG8_BAR; PG8_SCHED;
            PG8_LDA(At, 0, 1); PG8_STAGE(PG8_SB(0, 0), b2, voffB); PG8_STAGE(PG8_SB(0, 1), b2 + hstep, voffB); PG8_STAGE(PG8_SA(0, 0), a2, voffA);
            PG8_WAIT_V(8); PG8_WAIT_L(0); PG8_BAR; PG8_MMA(1, 0, At, B0); PG8_MMA(1, 1, At, B1); PG8_BAR; PG8_SCHED;
            PG8_LDB(B0, 1, 0); PG8_LDB(B1, 1, 1); PG8_SCHED; PG8_LDA(At, 1, 0); PG8_STAGE(PG8_SA(0, 1), a2 + hstep, voffA);
            PG8_WAIT_V(8); PG8_WAIT_L(0); PG8_BAR; PG8_MMA(0, 0, At, B0); PG8_MMA(0, 1, At, B1); PG8_BAR; PG8_SCHED;
            PG8_LDA(At, 1, 1); PG8_STAGE(PG8_SB(1, 0), b3, voffB); PG8_STAGE(PG8_SB(1, 1), b3 + hstep, voffB); PG8_STAGE(PG8_SA(1, 0), a3, voffA);
            PG8_WAIT_V(8); PG8_WAIT_L(0); PG8_BAR; PG8_MMA(1, 0, At, B0); PG8_MMA(1, 1, At, B1); PG8_BAR; PG8_SCHED;
            } else {
            PG8_LDB(B0, 0, 0); PG8_SCHED; PG8_LDA(At, 0, 0); PG8_STAGE(PG8_SA(1, 1), a1 + hstep, voffA);
            PG8_WAIT_L(8); PG8_BAR; PG8_WAIT_L(0); PG8_MMA(0, 0, At, B0); PG8_BAR; PG8_SCHED;
            PG8_LDB(B1, 0, 1); PG8_STAGE(PG8_SB(0, 0), b2, voffB);
            PG8_BAR; PG8_WAIT_L(0); PG8_MMA(0, 1, At, B1); PG8_BAR;
            PG8_LDA(At, 0, 1); PG8_STAGE(PG8_SA(0, 0), a2, voffA);
            PG8_BAR; PG8_WAIT_L(0); PG8_MMA(1, 0, At, B0); PG8_BAR; PG8_SCHED;
            PG8_STAGE(PG8_SB(0, 1), b2 + hstep, voffB);
            PG8_WAIT_V(6); PG8_BAR; PG8_MMA(1, 1, At, B1); PG8_BAR;
            PG8_LDB(B0, 1, 0); PG8_SCHED; PG8_LDA(At, 1, 0); PG8_STAGE(PG8_SA(0, 1), a2 + hstep, voffA);
            PG8_WAIT_L(8); PG8_BAR; PG8_WAIT_L(0); PG8_MMA(0, 0, At, B0); PG8_BAR; PG8_SCHED;
            PG8_LDB(B1, 1, 1); PG8_STAGE(PG8_SB(1, 0), b3, voffB);
            PG8_BAR; PG8_WAIT_L(0); PG8_MMA(0, 1, At, B1); PG8_BAR;
            PG8_LDA(At, 1, 1); PG8_STAGE(PG8_SA(1, 0), a3, voffA);
            PG8_BAR; PG8_WAIT_L(0); PG8_MMA(1, 0, At, B0); PG8_BAR; PG8_SCHED;
            PG8_STAGE(PG8_SB(1, 1), b3 + hstep, voffB);
            PG8_WAIT_V(6); PG8_BAR; PG8_MMA(1, 1, At, B1); PG8_BAR;
            }
        }
        if constexpr (ALIGN_EPI) { if (wr == 0) PG8_BAR; }
        if constexpr (!Epi::AFTER_DRAIN) { E(acc, cur, wr, wc, fr, fq); S.done(cur); }
        if (!has_next) break;
#pragma unroll
        for (int a = 0; a < 2; ++a)
#pragma unroll
            for (int b = 0; b < 2; ++b)
#pragma unroll
                for (int m = 0; m < 4; ++m)
#pragma unroll
                    for (int n = 0; n < 2; ++n) acc[a][b][m][n] = (f32x4){0.f, 0.f, 0.f, 0.f};
        cur = nxt; cA = nA; cB = nB; ++ui;
        if constexpr (ALIGN_EPI) { if (wr == 1) PG8_BAR; }
    }
    PG8_WAIT_V(0);
    if constexpr (!ALIGN_EPI) { if (wr == 0) PG8_BAR; }
    PG8_BAR;
    if constexpr (Epi::AFTER_DRAIN) { E.fused(acc, cur, wr, wc, fr, fq, lds, wid, lane); S.done(cur); }
#undef PG8_SA
#undef PG8_SB
#undef PG8_STAGE
#undef PG8_LDA
#undef PG8_LDB
#undef PG8_MMA
#undef PG8_WAIT_V
#undef PG8_WAIT_L
#undef PG8_BAR
#undef PG8_SCHED
}
}

constexpr int BATCH = 8, SEQ = 2048, D = 1024, FF = 2816, HD = 64, NH = 8, PLE = 256, NQKV = 3072;
constexpr int M = BATCH * SEQ;
constexpr float EPS = 1e-6f;
typedef unsigned short bf16;
typedef float f32x4 __attribute__((ext_vector_type(4)));
typedef unsigned v4u __attribute__((ext_vector_type(4)));
typedef unsigned v2u __attribute__((ext_vector_type(2)));
#define LAS __attribute__((address_space(3)))

constexpr size_t MiB = 1u << 20;
constexpr size_t WS_CTL = 0;
constexpr size_t WS_W1GU = 1 * MiB;
constexpr size_t WS_W1D  = 12 * MiB;
constexpr size_t WS_WIN  = 18 * MiB;
constexpr size_t WS_WOUT = 24 * MiB;
constexpr size_t WS_W2GU = 26 * MiB;
constexpr size_t WS_W2D  = 37 * MiB;
constexpr size_t WS_WP   = 43 * MiB;
constexpr size_t WS_WG   = 44 * MiB;
constexpr size_t WS_P    = 46 * MiB;
constexpr size_t WS_XN   = 54 * MiB;
constexpr size_t WS_BIG  = 86 * MiB;
constexpr size_t WS_F    = 182 * MiB;
constexpr size_t WS_END  = 246 * MiB;

__device__ __forceinline__ unsigned f2bf(float f) { unsigned u = __builtin_bit_cast(unsigned, f); return (u + 0x7fffu + ((u >> 16) & 1u)) >> 16; }
__device__ __forceinline__ unsigned pk2(float lo, float hi) { return f2bf(lo) | (f2bf(hi) << 16); }
__device__ __forceinline__ float bf2f(bf16 b) { return __builtin_bit_cast(float, (unsigned)b << 16); }
__device__ __forceinline__ float wave_sum(float v) {
#pragma unroll
    for (int o = 1; o < 64; o <<= 1) v += __shfl_xor(v, o);
    return v;
}
__device__ __forceinline__ float wave_max(float v) {
#pragma unroll
    for (int o = 1; o < 64; o <<= 1) v = fmaxf(v, __shfl_xor(v, o));
    return v;
}

__device__ __forceinline__ void transpose_item(const float* W, int K, int N, bf16* WT, int k0, int n0, int rowbase, LAS float* scr, int lane) {
#pragma unroll 8
    for (int i = 0; i < 32; ++i) { const int kk = 2 * i + (lane >> 5); scr[kk * 33 + (lane & 31)] = W[(size_t)(k0 + kk) * N + n0 + (lane & 31)]; }
    asm volatile("s_waitcnt lgkmcnt(0)" ::: "memory");
    const int c = lane & 7;
#pragma unroll
    for (int j = 0; j < 4; ++j) { const int n = (lane >> 3) + 8 * j; const LAS float* s = scr + (8 * c) * 33 + n;
        v4u o; o.x = pk2(s[0 * 33], s[1 * 33]); o.y = pk2(s[2 * 33], s[3 * 33]); o.z = pk2(s[4 * 33], s[5 * 33]); o.w = pk2(s[6 * 33], s[7 * 33]);
        *(v4u*)(WT + (size_t)(rowbase + n) * K + k0 + 8 * c) = o; }
    asm volatile("s_waitcnt lgkmcnt(0)" ::: "memory");
}
__device__ __forceinline__ void transpose_matrix_item(const float* W, int K, int N, bf16* WT, int mode, LAS float* scr, int item, int lane) {
    const int nblk = N / 32, kb = item / nblk, nb = item % nblk, k0 = 64 * kb, n0 = 32 * nb;
    const int rowbase = mode == 0 ? n0 : (256 * (n0 / 128) + (n0 % 128) + (mode == 2 ? 128 : 0));
    transpose_item(W, K, N, WT, k0, n0, rowbase, scr, lane);
}
struct ProArgs { const float* in[22]; unsigned char* ws; };
__global__ void __launch_bounds__(512) k_prologue(ProArgs a) {
    __shared__ float scr_all[8 * 64 * 33];
    const int tid = threadIdx.x, lane = tid & 63, wave = tid >> 6;
    LAS float* scr = (LAS float*)scr_all + wave * 64 * 33;
    const int gw = blockIdx.x * 8 + wave, NGW = gridDim.x * 8;
    unsigned char* ws = a.ws;
    constexpr int I_GU = (D / 64) * (FF / 32), I_DN = (FF / 64) * (D / 32), I_IN = (D / 64) * (NQKV / 32), I_SQ = (D / 64) * (D / 32), I_P = (PLE / 64) * (D / 32);
    constexpr int NITEMS = 4 * I_GU + 2 * I_DN + I_IN + 2 * I_SQ + I_P;
    for (int it = gw; it < NITEMS; it += NGW) {
        int r = it;
        if (r < I_GU) { transpose_matrix_item(a.in[4], D, FF, (bf16*)(ws + WS_W1GU), 1, scr, r, lane); continue; } r -= I_GU;
        if (r < I_GU) { transpose_matrix_item(a.in[5], D, FF, (bf16*)(ws + WS_W1GU), 2, scr, r, lane); continue; } r -= I_GU;
        if (r < I_DN) { transpose_matrix_item(a.in[6], FF, D, (bf16*)(ws + WS_W1D), 0, scr, r, lane); continue; } r -= I_DN;
        if (r < I_IN) { transpose_matrix_item(a.in[9], D, NQKV, (bf16*)(ws + WS_WIN), 0, scr, r, lane); continue; } r -= I_IN;
        if (r < I_SQ) { transpose_matrix_item(a.in[13], D, D, (bf16*)(ws + WS_WOUT), 0, scr, r, lane); continue; } r -= I_SQ;
        if (r < I_GU) { transpose_matrix_item(a.in[16], D, FF, (bf16*)(ws + WS_W2GU), 1, scr, r, lane); continue; } r -= I_GU;
        if (r < I_GU) { transpose_matrix_item(a.in[17], D, FF, (bf16*)(ws + WS_W2GU), 2, scr, r, lane); continue; } r -= I_GU;
        if (r < I_DN) { transpose_matrix_item(a.in[18], FF, D, (bf16*)(ws + WS_W2D), 0, scr, r, lane); continue; } r -= I_DN;
        if (r < I_P)  { transpose_matrix_item(a.in[19], PLE, D, (bf16*)(ws + WS_WP), 0, scr, r, lane); continue; } r -= I_P;
        transpose_matrix_item(a.in[20], D, D, (bf16*)(ws + WS_WG), 0, scr, r, lane);
    }
    const float* x = a.in[0]; const float* g = a.in[2]; bf16* XN = (bf16*)(ws + WS_XN);
    for (int m = gw; m < M; m += NGW) {
        const f32x4* xr = (const f32x4*)(x + (size_t)m * D) + lane; f32x4 v[4]; float s = 0.f;
#pragma unroll
        for (int j = 0; j < 4; ++j) { v[j] = xr[64 * j]; s += (v[j].x * v[j].x + v[j].y * v[j].y) + (v[j].z * v[j].z + v[j].w * v[j].w); }
        const float rstd = 1.0f / sqrtf(wave_sum(s) * (1.f / D) + EPS);
        v2u* o8 = (v2u*)(XN + (size_t)m * D) + lane;
#pragma unroll
        for (int j = 0; j < 4; ++j) { const f32x4 gg = ((const f32x4*)g)[lane + 64 * j]; v2u w; w.x = pk2(v[j].x * rstd * gg.x, v[j].y * rstd * gg.y); w.y = pk2(v[j].z * rstd * gg.z, v[j].w * rstd * gg.w); o8[64 * j] = w; }
    }
    const float* p = a.in[1]; bf16* Pb = (bf16*)(ws + WS_P);
    for (int m = gw; m < M; m += NGW) { const f32x4 v = ((const f32x4*)(p + (size_t)m * PLE))[lane]; v2u w; w.x = pk2(v.x, v.y); w.y = pk2(v.z, v.w); ((v2u*)(Pb + (size_t)m * PLE))[lane] = w; }
}

struct GemmArgs { const bf16* A; const bf16* Bt; void* out; int M, N, K, ld; };
template <class Epi, class OutT> __global__ void __launch_bounds__(512, 2) k_gemm(GemmArgs a) {
    extern __shared__ __attribute__((aligned(16))) unsigned char lds[];
    pg8::Gemm g{a.A, a.Bt, a.M, a.N, a.K};
    pg8::StaticOrder S; S.init(a.M, a.N, (int)gridDim.x, (int)blockIdx.x);
    Epi E{(OutT*)a.out, a.ld};
    pg8::gemm_phase<Epi, pg8::StaticOrder, true, true>((LAS unsigned char*)lds, g, S, E);
}

struct PostArgs { const float* F; const float* hin; float* hout; const float* gpost; const float* gnext; bf16* XN; float scale; int mode; };
__global__ void __launch_bounds__(256) k_post(PostArgs a) {
    const int lane = threadIdx.x & 63, m = blockIdx.x * 4 + (threadIdx.x >> 6);
    const f32x4* fr = (const f32x4*)(a.F + (size_t)m * D) + lane; const f32x4* hr = (const f32x4*)(a.hin + (size_t)m * D) + lane;
    f32x4 f[4], h[4]; float s = 0.f;
#pragma unroll
    for (int j = 0; j < 4; ++j) { f[j] = fr[64 * j]; h[j] = hr[64 * j]; s += (f[j].x * f[j].x + f[j].y * f[j].y) + (f[j].z * f[j].z + f[j].w * f[j].w); }
    const float r1 = a.scale / sqrtf(wave_sum(s) * (1.f / D) + EPS); float s2 = 0.f;
#pragma unroll
    for (int j = 0; j < 4; ++j) { const f32x4 g = ((const f32x4*)a.gpost)[lane + 64 * j]; h[j] = h[j] + f[j] * g * r1; s2 += (h[j].x * h[j].x + h[j].y * h[j].y) + (h[j].z * h[j].z + h[j].w * h[j].w); }
    f32x4* ho = (f32x4*)(a.hout + (size_t)m * D) + lane;
#pragma unroll
    for (int j = 0; j < 4; ++j) ho[64 * j] = h[j];
    const float r2 = a.mode == 1 ? 1.0f / sqrtf(wave_sum(s2) * (1.f / D) + EPS) : 1.0f;
    v2u* o8 = (v2u*)(a.XN + (size_t)m * D) + lane;
#pragma unroll
    for (int j = 0; j < 4; ++j) { f32x4 g = {1.f, 1.f, 1.f, 1.f}; if (a.mode == 1) g = ((const f32x4*)a.gnext)[lane + 64 * j];
        v2u w; w.x = pk2(h[j].x * r2 * g.x, h[j].y * r2 * g.y); w.y = pk2(h[j].z * r2 * g.z, h[j].w * r2 * g.w); o8[64 * j] = w; }
}
struct ONormArgs { const float* Fo; const float* gsb; const float* gch; bf16* O; };
__global__ void __launch_bounds__(256) k_onorm(ONormArgs a) {
    const int lane = threadIdx.x & 63, m = blockIdx.x * 4 + (threadIdx.x >> 6);
    const f32x4* fr = (const f32x4*)(a.Fo + (size_t)m * D) + lane; f32x4 f[4]; float sa = 0.f, sb = 0.f;
#pragma unroll
    for (int j = 0; j < 4; ++j) { f[j] = fr[64 * j]; const float q = (f[j].x * f[j].x + f[j].y * f[j].y) + (f[j].z * f[j].z + f[j].w * f[j].w); if (j < 2) sa += q; else sb += q; }
    const float ra = 1.0f / sqrtf(wave_sum(sa) * (1.f / 512) + EPS), rb = 1.0f / sqrtf(wave_sum(sb) * (1.f / 512) + EPS);
    v2u* o8 = (v2u*)(a.O + (size_t)m * D) + lane;
#pragma unroll
    for (int j = 0; j < 4; ++j) { const f32x4 g = j < 2 ? ((const f32x4*)a.gsb)[lane + 64 * j] : ((const f32x4*)a.gch)[lane + 64 * (j - 2)]; const float r = j < 2 ? ra : rb;
        v2u w; w.x = pk2(f[j].x * r * g.x, f[j].y * r * g.y); w.y = pk2(f[j].z * r * g.z, f[j].w * r * g.w); o8[64 * j] = w; }
}
struct FinalArgs { const float* F; const bf16* PP; const float* h; const float* g; float* out; };
__global__ void __launch_bounds__(256) k_final(FinalArgs a) {
    const int lane = threadIdx.x & 63, m = blockIdx.x * 4 + (threadIdx.x >> 6);
    const f32x4* fr = (const f32x4*)(a.F + (size_t)m * D) + lane; const v2u* pr = (const v2u*)(a.PP + (size_t)m * D) + lane;
    f32x4 e[4]; float s = 0.f;
#pragma unroll
    for (int j = 0; j < 4; ++j) { const f32x4 f = fr[64 * j]; const v2u pw = pr[64 * j];
        const f32x4 pv = {__builtin_bit_cast(float, pw.x << 16), __builtin_bit_cast(float, pw.x & 0xffff0000u), __builtin_bit_cast(float, pw.y << 16), __builtin_bit_cast(float, pw.y & 0xffff0000u)};
        e[j].x = pv.x / (1.0f + expf(-f.x)); e[j].y = pv.y / (1.0f + expf(-f.y)); e[j].z = pv.z / (1.0f + expf(-f.z)); e[j].w = pv.w / (1.0f + expf(-f.w));
        s += (e[j].x * e[j].x + e[j].y * e[j].y) + (e[j].z * e[j].z + e[j].w * e[j].w); }
    const float r = 1.0f / sqrtf(wave_sum(s) * (1.f / D) + EPS);
    const f32x4* hr = (const f32x4*)(a.h + (size_t)m * D) + lane; f32x4* orow = (f32x4*)(a.out + (size_t)m * D) + lane;
#pragma unroll
    for (int j = 0; j < 4; ++j) { const f32x4 g = ((const f32x4*)a.g)[lane + 64 * j]; orow[64 * j] = hr[64 * j] + e[j] * g * r; }
}

__device__ __forceinline__ float softplusf(float z) { return fmaxf(z, 0.f) + log1pf(expf(-fabsf(z))); }
__device__ __forceinline__ float dot64(const LAS float* q, const bf16* k) {
    float z = 0.f;
#pragma unroll
    for (int c = 0; c < 8; ++c) { const v4u w = ((const v4u*)k)[c];
        z += q[8 * c + 0] * __builtin_bit_cast(float, w.x << 16) + q[8 * c + 1] * __builtin_bit_cast(float, w.x & 0xffff0000u);
        z += q[8 * c + 2] * __builtin_bit_cast(float, w.y << 16) + q[8 * c + 3] * __builtin_bit_cast(float, w.y & 0xffff0000u);
        z += q[8 * c + 4] * __builtin_bit_cast(float, w.z << 16) + q[8 * c + 5] * __builtin_bit_cast(float, w.z & 0xffff0000u);
        z += q[8 * c + 6] * __builtin_bit_cast(float, w.w << 16) + q[8 * c + 7] * __builtin_bit_cast(float, w.w & 0xffff0000u); }
    return z;
}
struct AttnArgs { const bf16* QKV; const float* relb; float* Fo; };
__global__ void __launch_bounds__(256) k_attnA_naive(AttnArgs a) {
    __shared__ float qs_all[4 * 64];
    const int lane = threadIdx.x & 63, w = threadIdx.x >> 6; LAS float* qs = (LAS float*)qs_all + w * 64;
    const int gwave = blockIdx.x * 4 + w; const int t = gwave % SEQ, bh = gwave / SEQ, h = bh % NH, b = bh / NH;
    const bf16* qrow = a.QKV + (size_t)(b * SEQ + t) * NQKV + h * HD;
    const bf16* kb = a.QKV + (size_t)(b * SEQ) * NQKV + 512 + h * HD;
    const bf16* vb = a.QKV + (size_t)(b * SEQ) * NQKV + 1024 + h * HD;
    qs[lane] = bf2f(qrow[lane]);
    asm volatile("s_waitcnt lgkmcnt(0)" ::: "memory");
    float o = 0.f, carry = 0.f;
    for (int s0 = t - 1; s0 >= 0; s0 -= 64) {
        const int s = s0 - lane; const bool valid = s >= 0;
        float z = 0.f; if (valid) z = dot64(qs, kb + (size_t)s * NQKV) * 0.125f;
        const float lf = valid ? -softplusf(z) : 0.f;
        float incl = lf;
#pragma unroll
        for (int off = 1; off < 64; off <<= 1) { const float nb = __shfl_up(incl, off); if (lane >= off) incl += nb; }
        const float later = carry + incl - lf;
        const float wgt = valid ? expf(-softplusf(-z) + later) : 0.f;
        carry += __shfl(incl, 63);
        const int nj = s0 + 1 < 64 ? s0 + 1 : 64;
        for (int j = 0; j < nj; ++j) { const float aj = __shfl(wgt, j); o += aj * bf2f(vb[(size_t)(s0 - j) * NQKV + lane]); }
    }
    a.Fo[(size_t)(b * SEQ + t) * D + h * HD + lane] = o;
}
__global__ void __launch_bounds__(256) k_attnB_naive(AttnArgs a) {
    __shared__ float qs_all[4 * 64];
    const int lane = threadIdx.x & 63, w = threadIdx.x >> 6; LAS float* qs = (LAS float*)qs_all + w * 64;
    const int gwave = blockIdx.x * 4 + w; const int t = gwave % SEQ, bh = gwave / SEQ, h = bh % NH, b = bh / NH;
    const bf16* qrow = a.QKV + (size_t)(b * SEQ + t) * NQKV + 1536 + h * HD;
    const bf16* kb = a.QKV + (size_t)(b * SEQ) * NQKV + 2048 + h * HD;
    const bf16* vb = a.QKV + (size_t)(b * SEQ) * NQKV + 2560 + h * HD;
    const float* rb = a.relb + h * 257;
    qs[lane] = bf2f(qrow[lane]);
    asm volatile("s_waitcnt lgkmcnt(0)" ::: "memory");
    const int c = t / 64, c0 = c >= 8 ? c - 8 : 0, nch = c - c0 + 1, kstart = c0 * 64;
    float z[9]; float mx = -3.0e38f;
#pragma unroll
    for (int i = 0; i < 9; ++i) { z[i] = -3.0e38f; if (i < nch) { const int s = kstart + 64 * i + lane; int d = t - s; d = d < -128 ? -128 : (d > 128 ? 128 : d);
        z[i] = dot64(qs, kb + (size_t)s * NQKV) * 0.125f + rb[d + 128]; mx = fmaxf(mx, z[i]); } }
    mx = wave_max(mx); float sum = 0.f;
#pragma unroll
    for (int i = 0; i < 9; ++i) { z[i] = i < nch ? expf(z[i] - mx) : 0.f; sum += z[i]; }
    sum = wave_sum(sum); float o = 0.f;
#pragma unroll
    for (int i = 0; i < 9; ++i) if (i < nch) { for (int j = 0; j < 64; ++j) { const float pj = __shfl(z[i], j); o += pj * bf2f(vb[(size_t)(kstart + 64 * i + j) * NQKV + lane]); } }
    a.Fo[(size_t)(b * SEQ + t) * D + 512 + h * HD + lane] = o / sum;
}

extern "C" void kernel_launch(void* const* d_in, const int* in_sizes, int n_in, void* d_out, int out_size, void* d_ws, size_t ws_size, hipStream_t stream) {
    static int ok = 0;
    if (ok == 0) {
        if (n_in != 22 || in_sizes[0] != M * D || out_size != M * D || ws_size < WS_END) { fprintf(stderr, "kernel_launch: unexpected shapes n_in %d in0 %d out %d ws %zu\n", n_in, n_in > 0 ? in_sizes[0] : -1, out_size, ws_size); ok = -1; return; }
        const int LDSB = pg8::STAGE_BYTES;
        if (hipFuncSetAttribute((const void*)k_gemm<pg8::EpiF32, float>, hipFuncAttributeMaxDynamicSharedMemorySize, LDSB) != hipSuccess ||
            hipFuncSetAttribute((const void*)k_gemm<pg8::EpiBf16, bf16>, hipFuncAttributeMaxDynamicSharedMemorySize, LDSB) != hipSuccess ||
            hipFuncSetAttribute((const void*)k_gemm<pg8::EpiSwiGLU, bf16>, hipFuncAttributeMaxDynamicSharedMemorySize, LDSB) != hipSuccess) { fprintf(stderr, "kernel_launch: hipFuncSetAttribute failed\n"); ok = -1; return; }
        ok = 1;
    }
    if (ok < 0) return;
    unsigned char* ws = (unsigned char*)d_ws; const float* const* in = (const float* const*)d_in; float* out = (float*)d_out;
    bf16* XN = (bf16*)(ws + WS_XN); bf16* BIG = (bf16*)(ws + WS_BIG); float* F = (float*)(ws + WS_F); bf16* Pb = (bf16*)(ws + WS_P);
    const int LDSB = pg8::STAGE_BYTES, G = 256;
    ProArgs pa{}; for (int i = 0; i < 22; ++i) pa.in[i] = in[i]; pa.ws = ws;
    hipLaunchKernelGGL(k_prologue, dim3(512), dim3(512), 0, stream, pa);
    { GemmArgs g{XN, (const bf16*)(ws + WS_W1GU), BIG, M, 2 * FF, D, FF}; hipLaunchKernelGGL((k_gemm<pg8::EpiSwiGLU, bf16>), dim3(G), dim3(512), LDSB, stream, g); }
    { GemmArgs g{BIG, (const bf16*)(ws + WS_W1D), F, M, D, FF, D}; hipLaunchKernelGGL((k_gemm<pg8::EpiF32, float>), dim3(G), dim3(512), LDSB, stream, g); }
    { PostArgs p{F, in[0], out, in[3], in[7], XN, 0.5f, 1}; hipLaunchKernelGGL(k_post, dim3(M / 4), dim3(256), 0, stream, p); }
    { GemmArgs g{XN, (const bf16*)(ws + WS_WIN), BIG, M, NQKV, D, NQKV}; hipLaunchKernelGGL((k_gemm<pg8::EpiBf16, bf16>), dim3(G), dim3(512), LDSB, stream, g); }
    { AttnArgs t{BIG, in[12], F}; hipLaunchKernelGGL(k_attnA_naive, dim3(M * NH / 4), dim3(256), 0, stream, t); hipLaunchKernelGGL(k_attnB_naive, dim3(M * NH / 4), dim3(256), 0, stream, t); }
    { ONormArgs o{F, in[10], in[11], XN}; hipLaunchKernelGGL(k_onorm, dim3(M / 4), dim3(256), 0, stream, o); }
    { GemmArgs g{XN, (const bf16*)(ws + WS_WOUT), F, M, D, D, D}; hipLaunchKernelGGL((k_gemm<pg8::EpiF32, float>), dim3(G), dim3(512), LDSB, stream, g); }
    { PostArgs p{F, out, out, in[8], in[14], XN, 1.0f, 1}; hipLaunchKernelGGL(k_post, dim3(M / 4), dim3(256), 0, stream, p); }
    { GemmArgs g{XN, (const bf16*)(ws + WS_W2GU), BIG, M, 2 * FF, D, FF}; hipLaunchKernelGGL((k_gemm<pg8::EpiSwiGLU, bf16>), dim3(G), dim3(512), LDSB, stream, g); }
    { GemmArgs g{BIG, (const bf16*)(ws + WS_W2D), F, M, D, FF, D}; hipLaunchKernelGGL((k_gemm<pg8::EpiF32, float>), dim3(G), dim3(512), LDSB, stream, g); }
    { PostArgs p{F, out, out, in[15], in[15], XN, 0.5f, 2}; hipLaunchKernelGGL(k_post, dim3(M / 4), dim3(256), 0, stream, p); }
    { GemmArgs g{Pb, (const bf16*)(ws + WS_WP), BIG, M, D, PLE, D}; hipLaunchKernelGGL((k_gemm<pg8::EpiBf16, bf16>), dim3(G), dim3(512), LDSB, stream, g); }
    { GemmArgs g{XN, (const bf16*)(ws + WS_WG), F, M, D, D, D}; hipLaunchKernelGGL((k_gemm<pg8::EpiF32, float>), dim3(G), dim3(512), LDSB, stream, g); }
    { FinalArgs f{F, BIG, out, in[21], out}; hipLaunchKernelGGL(k_final, dim3(M / 4), dim3(256), 0, stream, f); }
}
```

```cpp
#include <hip/hip_runtime.h>
#include <cstdio>
#include <cstdint>
namespace pg8 {
#define PG8_LAS __attribute__((address_space(3)))
typedef unsigned short bf16_t;
typedef short bf16x8 __attribute__((ext_vector_type(8)));
typedef float f32x4 __attribute__((ext_vector_type(4)));
typedef unsigned u32x4 __attribute__((ext_vector_type(4)));
constexpr int BM = 256, BK = 64, HALF = 128, HTB = HALF * BK * 2  , STAGE_BYTES = 8 * HTB, NXCD = 8, WGM = 8;

__host__ __device__ __forceinline__ int lds_byte(int r, int c) { const int st = (r >> 4) * 2 + (c >> 5), rr = r & 15, cc = c & 31, ob = rr * 64 + cc * 2; return st * 1024 + (ob ^ (((ob >> 9) & 1) << 5)); }
__host__ __device__ __forceinline__ void stage_rc(int b, int& R, int& C) { const int st = b / 1024, sb = b % 1024, swz = sb ^ (((sb >> 9) & 1) << 5); R = (st >> 1) * 16 + swz / 64; C = (st & 1) * 32 + (swz % 64) / 2; }
__host__ __device__ __forceinline__ int perm32(int rho) { const int n = rho >> 4, i = rho & 15; return 8 * (i >> 2) + 4 * n + (i & 3); }

struct Unit { int pm, pn; };
struct Gemm { const bf16_t* A; const bf16_t* Bt; int M, N, K; };

struct StaticOrder {
    int nM, nN, nwg, G, c;
    __host__ __device__ void init(int M, int N, int G_, int c_) { nM = M / BM; nN = N / BM; nwg = nM * nN; G = G_; c = c_; }
    __host__ __device__ bool next(int i, Unit& u) const {
        const long L = (long)i * G + c; if (L >= nwg) return false;
        int wgid = (int)L; { const int q = nwg / NXCD, r = nwg % NXCD, xcd = wgid % NXCD, off = wgid / NXCD; wgid = (xcd < r ? xcd * (q + 1) : r * (q + 1) + (xcd - r) * q) + off; }
        const int nig = WGM * nN, gid = wgid / nig, fm = gid * WGM, gsz = (nM - fm) < WGM ? (nM - fm) : WGM;
        u.pm = fm + ((wgid % nig) % gsz); u.pn = (wgid % nig) / gsz; return true;
    }
    __device__ __forceinline__ void a_ready(const Unit&) const {}
    __device__ __forceinline__ void done(const Unit&) const {}
};

__device__ __forceinline__ unsigned cvt_pk_bf16(float lo, float hi) { unsigned r; asm volatile("v_cvt_pk_bf16_f32 %0, %1, %2" : "=v"(r) : "v"(lo), "v"(hi)); return r; }

struct EpiF32 {
    static constexpr bool PERM = false, AFTER_DRAIN = false;
    float* F; int ldc;
    __device__ __forceinline__ void operator()(const f32x4 (&acc)[2][2][4][2], const Unit& u, int wr, int wc, int fr, int fq) const {
        const int row0 = u.pm * BM + wr * 64 + fr, col0 = u.pn * BM + wc * 32 + 4 * fq;
#pragma unroll
        for (int ai = 0; ai < 2; ++ai)
#pragma unroll
            for (int m = 0; m < 4; ++m) { float* rowp = F + (size_t)(row0 + ai * HALF + m * 16) * ldc + col0;
#pragma unroll
                for (int bj = 0; bj < 2; ++bj)
#pragma unroll
                    for (int n = 0; n < 2; ++n) *(f32x4*)(rowp + bj * HALF + n * 16) = acc[ai][bj][m][n]; }
    }
};
struct EpiBf16 {
    static constexpr bool PERM = true, AFTER_DRAIN = false;
    bf16_t* O; int ldc;
    __device__ __forceinline__ void operator()(const f32x4 (&acc)[2][2][4][2], const Unit& u, int wr, int wc, int fr, int fq) const {
        const int row0 = u.pm * BM + wr * 64 + fr, col0 = u.pn * BM + wc * 32 + 8 * fq;
#pragma unroll
        for (int ai = 0; ai < 2; ++ai)
#pragma unroll
            for (int m = 0; m < 4; ++m) { bf16_t* rowp = O + (size_t)(row0 + ai * HALF + m * 16) * ldc + col0;
#pragma unroll
                for (int bj = 0; bj < 2; ++bj) { const f32x4 v0 = acc[ai][bj][m][0], v1 = acc[ai][bj][m][1];
                    u32x4 w; w.x = cvt_pk_bf16(v0[0], v0[1]); w.y = cvt_pk_bf16(v0[2], v0[3]); w.z = cvt_pk_bf16(v1[0], v1[1]); w.w = cvt_pk_bf16(v1[2], v1[3]);
                    *(u32x4*)(rowp + bj * HALF) = w; } }
    }
};
__device__ __forceinline__ float silu_mul(float g, float u) { return g * u * __builtin_amdgcn_rcpf(1.0f + __expf(-g)); }
struct EpiSwiGLU {
    static constexpr bool PERM = true, AFTER_DRAIN = false;
    bf16_t* H; int ldh;
    __device__ __forceinline__ void operator()(const f32x4 (&acc)[2][2][4][2], const Unit& u, int wr, int wc, int fr, int fq) const {
        const int row0 = u.pm * BM + wr * 64 + fr, col0 = u.pn * HALF + wc * 32 + 8 * fq;
#pragma unroll
        for (int ai = 0; ai < 2; ++ai)
#pragma unroll
            for (int m = 0; m < 4; ++m) { bf16_t* rowp = H + (size_t)(row0 + ai * HALF + m * 16) * ldh + col0;
                const f32x4 g0 = acc[ai][0][m][0], g1 = acc[ai][0][m][1], u0 = acc[ai][1][m][0], u1 = acc[ai][1][m][1];
                u32x4 w; w.x = cvt_pk_bf16(silu_mul(g0[0], u0[0]), silu_mul(g0[1], u0[1])); w.y = cvt_pk_bf16(silu_mul(g0[2], u0[2]), silu_mul(g0[3], u0[3]));
                w.z = cvt_pk_bf16(silu_mul(g1[0], u1[0]), silu_mul(g1[1], u1[1])); w.w = cvt_pk_bf16(silu_mul(g1[2], u1[2]), silu_mul(g1[3], u1[3]));
                *(u32x4*)rowp = w; }
    }
};

template <class Epi, class Sched, bool ALIGN_EPI = false, bool SP2 = false>
__device__ __forceinline__ void gemm_phase(PG8_LAS unsigned char* lds, const Gemm g, const Sched& S, const Epi& E) {
    const int tid = threadIdx.x, wid = __builtin_amdgcn_readfirstlane(tid >> 6), lane = tid & 63, wr = wid >> 2, wc = wid & 3, fr = lane & 15, fq = lane >> 4;
    const int K = g.K, nt = K / BK;
    unsigned voffA[2], voffB[2];
#pragma unroll
    for (int i = 0; i < 2; ++i) { int R, C; stage_rc(tid * 16 + i * 8192, R, C); const int Rb = Epi::PERM ? ((R & ~31) + perm32(R & 31)) : R;
        voffA[i] = (unsigned)(R * K + C) * 2u; voffB[i] = (unsigned)(Rb * K + C) * 2u; }
    const size_t kstep = (size_t)(BK * 2);
    const size_t hstep = (size_t)HALF * K * 2;
    const size_t tstep = 2 * hstep;
    const unsigned ldsw = (unsigned)wid * 1024u;
    const int aoff = lds_byte(wr * 64 + fr, fq * 8), boff = lds_byte(wc * 32 + fr, fq * 8);
#define PG8_SA(b, h) (((b) * 2 + (h)) * HTB)
#define PG8_SB(b, h) ((4 + (b) * 2 + (h)) * HTB)
#define PG8_STAGE(bufoff, gbase, voff) do { _Pragma("unroll") for (int _i = 0; _i < 2; ++_i) \
        __builtin_amdgcn_global_load_lds((const unsigned*)((const char*)(gbase) + (voff)[_i]), (PG8_LAS unsigned*)(lds + (bufoff) + ldsw + _i * 8192), 16, 0, 0); } while (0)
#define PG8_LDA(dst, b, h) do { _Pragma("unroll") for (int m = 0; m < 4; ++m) _Pragma("unroll") for (int k = 0; k < 2; ++k) dst[m][k] = *(const PG8_LAS bf16x8*)(lds + PG8_SA(b, h) + aoff + m * 2048 + k * 1024); } while (0)
#define PG8_LDB(dst, b, h) do { _Pragma("unroll") for (int n = 0; n < 2; ++n) _Pragma("unroll") for (int k = 0; k < 2; ++k) dst[n][k] = *(const PG8_LAS bf16x8*)(lds + PG8_SB(b, h) + boff + n * 2048 + k * 1024); } while (0)
#define PG8_MMA(ai, bj, At, Bt) do { __builtin_amdgcn_s_setprio(1); _Pragma("unroll") for (int m = 0; m < 4; ++m) _Pragma("unroll") for (int n = 0; n < 2; ++n) _Pragma("unroll") for (int k = 0; k < 2; ++k) \
        acc[ai][bj][m][n] = __builtin_amdgcn_mfma_f32_16x16x32_bf16(Bt[n][k], At[m][k], acc[ai][bj][m][n], 0, 0, 0); __builtin_amdgcn_s_setprio(0); } while (0)
#define PG8_WAIT_V(n) asm volatile("s_waitcnt vmcnt(" #n ")" ::: "memory")
#define PG8_WAIT_L(n) asm volatile("s_waitcnt lgkmcnt(" #n ")" ::: "memory")
#define PG8_BAR __builtin_amdgcn_s_barrier()
#define PG8_SCHED __builtin_amdgcn_sched_barrier(0)
    Unit cur, nxt; int ui = 0;
    if (!S.next(0, cur)) return;
    f32x4 acc[2][2][4][2];
#pragma unroll
    for (int a = 0; a < 2; ++a)
#pragma unroll
        for (int b = 0; b < 2; ++b)
#pragma unroll
            for (int m = 0; m < 4; ++m)
#pragma unroll
                for (int n = 0; n < 2; ++n) acc[a][b][m][n] = (f32x4){0.f, 0.f, 0.f, 0.f};
    bf16x8 At[4][2], B0[2][2], B1[2][2];
    const char* cA = (const char*)g.A + (size_t)cur.pm * tstep; const char* cB = (const char*)g.Bt + (size_t)cur.pn * tstep;
    S.a_ready(cur);
    if constexpr (SP2) {
        PG8_STAGE(PG8_SB(0, 0), cB, voffB); PG8_STAGE(PG8_SB(0, 1), cB + hstep, voffB); PG8_STAGE(PG8_SA(0, 0), cA, voffA); PG8_STAGE(PG8_SA(0, 1), cA + hstep, voffA);
        if (wr == 1) PG8_BAR;
        PG8_WAIT_V(2); PG8_BAR;
        PG8_STAGE(PG8_SB(1, 0), cB + kstep, voffB); PG8_STAGE(PG8_SA(1, 0), cA + kstep, voffA); PG8_STAGE(PG8_SB(1, 1), cB + hstep + kstep, voffB);
        PG8_WAIT_V(6); PG8_BAR;
    } else {
        PG8_STAGE(PG8_SB(0, 0), cB, voffB); PG8_STAGE(PG8_SA(0, 0), cA, voffA); PG8_STAGE(PG8_SB(0, 1), cB + hstep, voffB); PG8_STAGE(PG8_SA(0, 1), cA + hstep, voffA);
        if (wr == 1) PG8_BAR;
        PG8_WAIT_V(4); PG8_BAR;
        PG8_STAGE(PG8_SB(1, 0), cB + kstep, voffB); PG8_STAGE(PG8_SA(1, 0), cA + kstep, voffA); PG8_STAGE(PG8_SB(1, 1), cB + hstep + kstep, voffB);
        PG8_WAIT_V(6); PG8_BAR;
    }
    for (;;) {
        const bool has_next = S.next(ui + 1, nxt);
        const char* nA = has_next ? (const char*)g.A + (size_t)nxt.pm * tstep : cA; const char* nB = has_next ? (const char*)g.Bt + (size_t)nxt.pn * tstep : cB;
        for (int t = 0; t < nt; t += 2) {
            const bool last = (t == nt - 2);
            const char* a1 = cA + (size_t)(t + 1) * kstep;
            const char* a2 = last ? nA : cA + (size_t)(t + 2) * kstep; const char* b2 = last ? nB : cB + (size_t)(t + 2) * kstep;
            const char* a3 = a2 + kstep; const char* b3 = b2 + kstep;
            if (last && has_next) S.a_ready(nxt);
            if constexpr (SP2) {
            PG8_LDB(B0, 0, 0); PG8_LDB(B1, 0, 1); PG8_SCHED; PG8_LDA(At, 0, 0); PG8_STAGE(PG8_SA(1, 1), a1 + hstep, voffA);
            PG8_WAIT_V(8); PG8_WAIT_L(0); PG8_BAR; PG8_MMA(0, 0, At, B0); PG8_MMA(0, 1, At, B1); PG8_BAR; PG8_SCHED;
            PG8_LDA(At, 0, 1); PG8_STAGE(PG8_SB(0, 0), b2, voffB); PG8_STAGE(PG8_SB(0, 1), b2 + hstep, voffB); PG8_STAGE(PG8_SA(0, 0), a2, voffA);
            PG8_WAIT_V(8); PG8_WAIT_L(0); PG8_BAR; PG8_MMA(1, 0, At, B0); PG8_MMA(1, 1, At, B1); PG8_BAR; PG8_SCHED;
            PG8_LDB(B0, 1, 0); PG8_LDB(B1, 1, 1); PG8_SCHED; PG8_LDA(At, 1, 0); PG8_STAGE(PG8_SA(0, 1), a2 + hstep, voffA);
            PG8_WAIT_V(8); PG8_WAIT_L(0); PG8_BAR; PG8_MMA(0, 0, At, B0); PG8_MMA(0, 1, At, B1); PG8_BAR; PG8_SCHED;
            PG8_LDA(At, 1, 1); PG8_STAGE(PG8_SB(1, 0), b3, voffB); PG8_STAGE(PG8_SB(1, 1), b3 + hstep, voffB); PG8_STAGE(PG8_SA(1, 0), a3, voffA);
            PG8_WAIT_V(8); PG8_WAIT_L(0); PG8_BAR; PG8_MMA(1, 0, At, B0); PG8_MMA(1, 1, At, B1); PG8_BAR; PG8_SCHED;
            } else {
            PG8_LDB(B0, 0, 0); PG8_SCHED; PG8_LDA(At, 0, 0); PG8_STAGE(PG8_SA(1, 1), a1 + hstep, voffA);
            PG8_WAIT_L(8); PG8_BAR; PG8_WAIT_L(0); PG8_MMA(0, 0, At, B0); PG8_BAR; PG8_SCHED;
            PG8_LDB(B1, 0, 1); PG8_STAGE(PG8_SB(0, 0), b2, voffB);
            PG8_BAR; PG8_WAIT_L(0); PG8_MMA(0, 1, At, B1); PG8_BAR;
            PG8_LDA(At, 0, 1); PG8_STAGE(PG8_SA(0, 0), a2, voffA);
            PG8_BAR; PG8_WAIT_L(0); PG8_MMA(1, 0, At, B0); PG8_BAR; PG8_SCHED;
            PG8_STAGE(PG8_SB(0, 1), b2 + hstep, voffB);
            PG8_WAIT_V(6); PG8_BAR; PG8_MMA(1, 1, At, B1); PG8_BAR;
            PG8_LDB(B0, 1, 0); PG8_SCHED; PG8_LDA(At, 1, 0); PG8_STAGE(PG8_SA(0, 1), a2 + hstep, voffA);
            PG8_WAIT_L(8); PG8_BAR; PG8_WAIT_L(0); PG8_MMA(0, 0, At, B0); PG8_BAR; PG8_SCHED;
            PG8_LDB(B1, 1, 1); PG8_STAGE(PG8_SB(1, 0), b3, voffB);
            PG8_BAR; PG8_WAIT_L(0); PG8_MMA(0, 1, At, B1); PG8_BAR;
            PG8_LDA(At, 1, 1); PG8_STAGE(PG8_SA(1, 0), a3, voffA);
            PG8_BAR; PG8_WAIT_L(0); PG8_MMA(1, 0, At, B0); PG8_BAR; PG8_SCHED;
            PG8_STAGE(PG8_SB(1, 1), b3 + hstep, voffB);
            PG8_WAIT_V(6); PG8_BAR; PG8_MMA(1, 1, At, B1); PG8_BAR;
            }
        }
        if constexpr (ALIGN_EPI) { if (wr == 0) PG8_BAR; }
        if constexpr (!Epi::AFTER_DRAIN) { E(acc, cur, wr, wc, fr, fq); S.done(cur); }
        if (!has_next) break;
#pragma unroll
        for (int a = 0; a < 2; ++a)
#pragma unroll
            for (int b = 0; b < 2; ++b)
#pragma unroll
                for (int m = 0; m < 4; ++m)
#pragma unroll
                    for (int n = 0; n < 2; ++n) acc[a][b][m][n] = (f32x4){0.f, 0.f, 0.f, 0.f};
        cur = nxt; cA = nA; cB = nB; ++ui;
        if constexpr (ALIGN_EPI) { if (wr == 1) PG8_BAR; }
    }
    PG8_WAIT_V(0);
    if constexpr (!ALIGN_EPI) { if (wr == 0) PG8_BAR; }
    PG8_BAR;
    if constexpr (Epi::AFTER_DRAIN) { E.fused(acc, cur, wr, wc, fr, fq, lds, wid, lane); S.done(cur); }
#undef PG8_SA
#undef PG8_SB
#undef PG8_STAGE
#undef PG8_LDA
#undef PG8_LDB
#undef PG8_MMA
#undef PG8_WAIT_V
#undef PG8_WAIT_L
#undef PG8_BAR
#undef PG8_SCHED
}
}
constexpr int BATCH = 8, SEQ = 2048, D = 1024, FF = 2816, HD = 64, NH = 8, PLE = 256, NQKV = 3072;
constexpr int M = BATCH * SEQ;
constexpr float EPS = 1e-6f;
typedef unsigned short bf16;
typedef float f32x4 __attribute__((ext_vector_type(4)));
typedef unsigned v4u __attribute__((ext_vector_type(4)));
typedef unsigned v2u __attribute__((ext_vector_type(2)));
#define LAS __attribute__((address_space(3)))

constexpr size_t MiB = 1u << 20;
constexpr size_t WS_CTL = 0, CTL_ZERO_BYTES = 1 * MiB;
constexpr int CW_BAR = 4096;
constexpr size_t WS_W1GU = 1 * MiB;
constexpr size_t WS_W1D  = 12 * MiB;
constexpr size_t WS_WIN  = 18 * MiB;
constexpr size_t WS_WOUT = 24 * MiB;
constexpr size_t WS_W2GU = 26 * MiB;
constexpr size_t WS_W2D  = 37 * MiB;
constexpr size_t WS_WP   = 43 * MiB;
constexpr size_t WS_WG   = 44 * MiB;
constexpr size_t WS_P    = 46 * MiB;
constexpr size_t WS_XN   = 54 * MiB;
constexpr size_t WS_BIG  = 86 * MiB;
constexpr size_t WS_F    = 182 * MiB;
constexpr size_t WS_END  = 246 * MiB;

__device__ __forceinline__ unsigned f2bf(float f) { unsigned u = __builtin_bit_cast(unsigned, f); return (u + 0x7fffu + ((u >> 16) & 1u)) >> 16; }
__device__ __forceinline__ unsigned pk2(float lo, float hi) { return f2bf(lo) | (f2bf(hi) << 16); }
__device__ __forceinline__ float bf2f(bf16 b) { return __builtin_bit_cast(float, (unsigned)b << 16); }
__device__ __forceinline__ float wave_sum(float v) {
#pragma unroll
    for (int o = 1; o < 64; o <<= 1) v += __shfl_xor(v, o);
    return v;
}
__device__ __forceinline__ float wave_max(float v) {
#pragma unroll
    for (int o = 1; o < 64; o <<= 1) v = fmaxf(v, __shfl_xor(v, o));
    return v;
}

__device__ __forceinline__ void transpose_item(const float* W, int K, int N, bf16* WT, int k0, int n0, int rowbase, LAS float* scr, int lane) {
#pragma unroll 8
    for (int i = 0; i < 32; ++i) { const int kk = 2 * i + (lane >> 5); scr[kk * 33 + (lane & 31)] = W[(size_t)(k0 + kk) * N + n0 + (lane & 31)]; }
    asm volatile("s_waitcnt lgkmcnt(0)" ::: "memory");
    const int c = lane & 7;
#pragma unroll
    for (int j = 0; j < 4; ++j) { const int n = (lane >> 3) + 8 * j; const LAS float* s = scr + (8 * c) * 33 + n;
        v4u o; o.x = pk2(s[0 * 33], s[1 * 33]); o.y = pk2(s[2 * 33], s[3 * 33]); o.z = pk2(s[4 * 33], s[5 * 33]); o.w = pk2(s[6 * 33], s[7 * 33]);
        *(v4u*)(WT + (size_t)(rowbase + n) * K + k0 + 8 * c) = o; }
    asm volatile("s_waitcnt lgkmcnt(0)" ::: "memory");
}
__device__ __forceinline__ void transpose_matrix_item(const float* W, int K, int N, bf16* WT, int mode, LAS float* scr, int item, int lane) {
    const int nblk = N / 32, kb = item / nblk, nb = item % nblk, k0 = 64 * kb, n0 = 32 * nb;
    const int rowbase = mode == 0 ? n0 : (256 * (n0 / 128) + (n0 % 128) + (mode == 2 ? 128 : 0));
    transpose_item(W, K, N, WT, k0, n0, rowbase, scr, lane);
}

#define GAS __attribute__((address_space(1)))
typedef GAS unsigned gu32;
#define RLX_AGENT __ATOMIC_RELAXED, __HIP_MEMORY_SCOPE_AGENT
constexpr int RING_OFF = 0, RING_BYTES = 131072;
constexpr int LDSCTL_OFF = RING_BYTES, MISC_OFF = LDSCTL_OFF + 320;
constexpr int LDS_BYTES = 147456;
constexpr int NWAVES = 8;
#define XB_TMO      128
#define XB_XCNT(j)  (256  + 64 * (j))
#define XB_XSUB(j)  (1280 + 64 * (j))
#define XB_XGEN(j)  (2304 + 64 * (j))
#define XB_TOP      3328
#define XB_TOPGEN   3392
#define XCD_BAR_WORDS 3456
#define XB_SPIN_CAP (1u << 18)

__device__ __forceinline__ unsigned xb_ld(unsigned* p)              { return __hip_atomic_load(p, __ATOMIC_RELAXED, __HIP_MEMORY_SCOPE_AGENT); }
__device__ __forceinline__ unsigned xb_add(unsigned* p, unsigned v) { return __hip_atomic_fetch_add(p, v, __ATOMIC_RELAXED, __HIP_MEMORY_SCOPE_AGENT); }
__device__ __forceinline__ unsigned xb_xcc_id() { return (unsigned)__builtin_amdgcn_s_getreg((3 << 11) | 20) & 0xFu; }
#define XB_SPIN(cond, bar) do { unsigned _sp = 0; while (cond) { __builtin_amdgcn_s_sleep(1); \
    if ((++_sp & 255u) == 0u) { if (xb_ld(&(bar)[XB_TMO])) break; if (_sp > XB_SPIN_CAP) { atomicAdd(&(bar)[XB_TMO], 1u); break; } } } } while (0)

struct XcdBarrier {
    unsigned* bar; unsigned x;
    volatile LAS unsigned* st;
};

__device__ __forceinline__ XcdBarrier xcd_barrier_post(unsigned* bar, volatile LAS unsigned* st) {
    XcdBarrier b; b.bar = bar; b.x = xb_xcc_id(); b.st = st;
    if (threadIdx.x == 0) (void)xb_add(&bar[XB_XCNT(b.x)], 1u);
    return b;
}
__device__ __forceinline__ void xcd_barrier_complete(unsigned* bar, unsigned x, unsigned& nloc, unsigned& nx) {
    const unsigned G = gridDim.x * gridDim.y * gridDim.z;
    unsigned sum, cnt, mine, sp = 0u;
    for (;;) {
        sum = 0u; cnt = 0u; mine = 0u;
#pragma unroll
        for (unsigned j = 0; j < 16; ++j) { const unsigned c = xb_ld(&bar[XB_XCNT(j)]); sum += c; cnt += (c > 0u) ? 1u : 0u; mine = (j == x) ? c : mine; }
        if (sum == G) break;
        __builtin_amdgcn_s_sleep(1);
        if ((++sp & 255u) == 0u) { if (xb_ld(&bar[XB_TMO])) break; if (sp > XB_SPIN_CAP) { atomicAdd(&bar[XB_TMO], 1u); break; } }
    }
    nloc = mine > 0u ? mine : 1u; nx = cnt > 0u ? cnt : 1u;
}

__device__ __forceinline__ void xcd_barrier(const XcdBarrier& b) {
    asm volatile("s_waitcnt vmcnt(0)" ::: "memory");
    __syncthreads();
    if (threadIdx.x == 0) {
        unsigned* bar = b.bar;
        __builtin_amdgcn_s_waitcnt(0);
        unsigned nloc = b.st[0], nx = b.st[1];
        if (nloc == 0u) { xcd_barrier_complete(bar, b.x, nloc, nx); b.st[0] = nloc; b.st[1] = nx; }
        const unsigned old = xb_add(&bar[XB_XSUB(b.x)], 1u);
        const unsigned gen = old / nloc;
        if (old + 1u == (gen + 1u) * nloc) {
            __builtin_amdgcn_fence(__ATOMIC_RELEASE, "agent");
            asm volatile("s_waitcnt vmcnt(0)" ::: "memory");
            const unsigned og = xb_add(&bar[XB_TOP], 1u);
            const unsigned tg = og / nx;
            if (og + 1u == (tg + 1u) * nx) xb_add(&bar[XB_TOPGEN], 1u);
            else XB_SPIN(xb_ld(&bar[XB_TOPGEN]) == tg, bar);
            __builtin_amdgcn_fence(__ATOMIC_ACQUIRE, "agent");
            xb_add(&bar[XB_XGEN(b.x)], 1u);
            asm volatile("s_waitcnt vmcnt(0)" ::: "memory");
        } else {
            XB_SPIN(xb_ld(&bar[XB_XGEN(b.x)]) == gen, bar);
            __builtin_amdgcn_fence(__ATOMIC_ACQUIRE, "agent");
            asm volatile("s_waitcnt vmcnt(0)" ::: "memory");
        }
    }
    __syncthreads();
}


struct Args { const float* in[22]; float* out; unsigned char* ws; };
struct Ctx { LAS unsigned char* lds; int tid, lane, wave, gw, NGW; };

__device__ __forceinline__ void p_prologue(const Args& a, const Ctx& c) {
    LAS float* scr = (LAS float*)(c.lds + RING_OFF + c.wave * 16384);
    const int lane = c.lane, gw = c.gw, NGW = c.NGW; unsigned char* ws = a.ws;
    constexpr int I_GU = (D / 64) * (FF / 32), I_DN = (FF / 64) * (D / 32), I_IN = (D / 64) * (NQKV / 32), I_SQ = (D / 64) * (D / 32), I_P = (PLE / 64) * (D / 32);
    constexpr int NITEMS = 4 * I_GU + 2 * I_DN + I_IN + 2 * I_SQ + I_P;
    for (int it = gw; it < NITEMS; it += NGW) {
        int r = it;
        if (r < I_GU) { transpose_matrix_item(a.in[4], D, FF, (bf16*)(ws + WS_W1GU), 1, scr, r, lane); continue; } r -= I_GU;
        if (r < I_GU) { transpose_matrix_item(a.in[5], D, FF, (bf16*)(ws + WS_W1GU), 2, scr, r, lane); continue; } r -= I_GU;
        if (r < I_DN) { transpose_matrix_item(a.in[6], FF, D, (bf16*)(ws + WS_W1D), 0, scr, r, lane); continue; } r -= I_DN;
        if (r < I_IN) { transpose_matrix_item(a.in[9], D, NQKV, (bf16*)(ws + WS_WIN), 0, scr, r, lane); continue; } r -= I_IN;
        if (r < I_SQ) { transpose_matrix_item(a.in[13], D, D, (bf16*)(ws + WS_WOUT), 0, scr, r, lane); continue; } r -= I_SQ;
        if (r < I_GU) { transpose_matrix_item(a.in[16], D, FF, (bf16*)(ws + WS_W2GU), 1, scr, r, lane); continue; } r -= I_GU;
        if (r < I_GU) { transpose_matrix_item(a.in[17], D, FF, (bf16*)(ws + WS_W2GU), 2, scr, r, lane); continue; } r -= I_GU;
        if (r < I_DN) { transpose_matrix_item(a.in[18], FF, D, (bf16*)(ws + WS_W2D), 0, scr, r, lane); continue; } r -= I_DN;
        if (r < I_P)  { transpose_matrix_item(a.in[19], PLE, D, (bf16*)(ws + WS_WP), 0, scr, r, lane); continue; } r -= I_P;
        transpose_matrix_item(a.in[20], D, D, (bf16*)(ws + WS_WG), 0, scr, r, lane);
    }
    const float* x = a.in[0]; const float* g = a.in[2]; bf16* XN = (bf16*)(ws + WS_XN);
    for (int m = gw; m < M; m += NGW) {
        const f32x4* xr = (const f32x4*)(x + (size_t)m * D) + lane; f32x4 v[4]; float s = 0.f;
#pragma unroll
        for (int j = 0; j < 4; ++j) { v[j] = xr[64 * j]; s += (v[j].x * v[j].x + v[j].y * v[j].y) + (v[j].z * v[j].z + v[j].w * v[j].w); }
        const float rstd = 1.0f / sqrtf(wave_sum(s) * (1.f / D) + EPS);
        v2u* o8 = (v2u*)(XN + (size_t)m * D) + lane;
#pragma unroll
        for (int j = 0; j < 4; ++j) { const f32x4 gg = ((const f32x4*)g)[lane + 64 * j]; v2u w; w.x = pk2(v[j].x * rstd * gg.x, v[j].y * rstd * gg.y); w.y = pk2(v[j].z * rstd * gg.z, v[j].w * rstd * gg.w); o8[64 * j] = w; }
    }
    const float* p = a.in[1]; bf16* Pb = (bf16*)(ws + WS_P);
    for (int m = gw; m < M; m += NGW) { const f32x4 v = ((const f32x4*)(p + (size_t)m * PLE))[lane]; v2u w; w.x = pk2(v.x, v.y); w.y = pk2(v.z, v.w); ((v2u*)(Pb + (size_t)m * PLE))[lane] = w; }
}

__device__ __forceinline__ void p_post(const Ctx& c, const float* F, const float* hin, float* hout, const float* gpost, const float* gnext, bf16* XN, float scale, int mode) {
    const int lane = c.lane;
    for (int m = c.gw; m < M; m += c.NGW) {
        const f32x4* fr = (const f32x4*)(F + (size_t)m * D) + lane; const f32x4* hr = (const f32x4*)(hin + (size_t)m * D) + lane;
        f32x4 f[4], h[4]; float s = 0.f;
#pragma unroll
        for (int j = 0; j < 4; ++j) { f[j] = fr[64 * j]; h[j] = hr[64 * j]; s += (f[j].x * f[j].x + f[j].y * f[j].y) + (f[j].z * f[j].z + f[j].w * f[j].w); }
        const float r1 = scale / sqrtf(wave_sum(s) * (1.f / D) + EPS); float s2 = 0.f;
#pragma unroll
        for (int j = 0; j < 4; ++j) { const f32x4 g = ((const f32x4*)gpost)[lane + 64 * j]; h[j] = h[j] + f[j] * g * r1; s2 += (h[j].x * h[j].x + h[j].y * h[j].y) + (h[j].z * h[j].z + h[j].w * h[j].w); }
        f32x4* ho = (f32x4*)(hout + (size_t)m * D) + lane;
#pragma unroll
        for (int j = 0; j < 4; ++j) ho[64 * j] = h[j];
        const float r2 = mode == 1 ? 1.0f / sqrtf(wave_sum(s2) * (1.f / D) + EPS) : 1.0f;
        v2u* o8 = (v2u*)(XN + (size_t)m * D) + lane;
#pragma unroll
        for (int j = 0; j < 4; ++j) { f32x4 g = {1.f, 1.f, 1.f, 1.f}; if (mode == 1) g = ((const f32x4*)gnext)[lane + 64 * j];
            v2u w; w.x = pk2(h[j].x * r2 * g.x, h[j].y * r2 * g.y); w.y = pk2(h[j].z * r2 * g.z, h[j].w * r2 * g.w); o8[64 * j] = w; }
    }
}
__device__ __forceinline__ void p_onorm(const Ctx& c, const float* Fo, const float* gsb, const float* gch, bf16* O) {
    const int lane = c.lane;
    for (int m = c.gw; m < M; m += c.NGW) {
        const f32x4* fr = (const f32x4*)(Fo + (size_t)m * D) + lane; f32x4 f[4]; float sa = 0.f, sb = 0.f;
#pragma unroll
        for (int j = 0; j < 4; ++j) { f[j] = fr[64 * j]; const float q = (f[j].x * f[j].x + f[j].y * f[j].y) + (f[j].z * f[j].z + f[j].w * f[j].w); if (j < 2) sa += q; else sb += q; }
        const float ra = 1.0f / sqrtf(wave_sum(sa) * (1.f / 512) + EPS), rb = 1.0f / sqrtf(wave_sum(sb) * (1.f / 512) + EPS);
        v2u* o8 = (v2u*)(O + (size_t)m * D) + lane;
#pragma unroll
        for (int j = 0; j < 4; ++j) { const f32x4 g = j < 2 ? ((const f32x4*)gsb)[lane + 64 * j] : ((const f32x4*)gch)[lane + 64 * (j - 2)]; const float r = j < 2 ? ra : rb;
            v2u w; w.x = pk2(f[j].x * r * g.x, f[j].y * r * g.y); w.y = pk2(f[j].z * r * g.z, f[j].w * r * g.w); o8[64 * j] = w; }
    }
}
__device__ __forceinline__ void p_final(const Ctx& c, const float* F, const bf16* PP, const float* h, const float* g, float* out) {
    const int lane = c.lane;
    for (int m = c.gw; m < M; m += c.NGW) {
        const f32x4* fr = (const f32x4*)(F + (size_t)m * D) + lane; const v2u* pr = (const v2u*)(PP + (size_t)m * D) + lane;
        f32x4 e[4]; float s = 0.f;
#pragma unroll
        for (int j = 0; j < 4; ++j) { const f32x4 f = fr[64 * j]; const v2u pw = pr[64 * j];
            const f32x4 pv = {__builtin_bit_cast(float, pw.x << 16), __builtin_bit_cast(float, pw.x & 0xffff0000u), __builtin_bit_cast(float, pw.y << 16), __builtin_bit_cast(float, pw.y & 0xffff0000u)};
            e[j].x = pv.x / (1.0f + expf(-f.x)); e[j].y = pv.y / (1.0f + expf(-f.y)); e[j].z = pv.z / (1.0f + expf(-f.z)); e[j].w = pv.w / (1.0f + expf(-f.w));
            s += (e[j].x * e[j].x + e[j].y * e[j].y) + (e[j].z * e[j].z + e[j].w * e[j].w); }
        const float r = 1.0f / sqrtf(wave_sum(s) * (1.f / D) + EPS);
        const f32x4* hr = (const f32x4*)(h + (size_t)m * D) + lane; f32x4* orow = (f32x4*)(out + (size_t)m * D) + lane;
#pragma unroll
        for (int j = 0; j < 4; ++j) { const f32x4 g4 = ((const f32x4*)g)[lane + 64 * j]; orow[64 * j] = hr[64 * j] + e[j] * g4 * r; }
    }
}

__device__ __forceinline__ float softplusf(float z) { return fmaxf(z, 0.f) + log1pf(expf(-fabsf(z))); }
__device__ __forceinline__ float dot64(const LAS float* q, const bf16* k) {
    float z = 0.f;
#pragma unroll
    for (int c = 0; c < 8; ++c) { const v4u w = ((const v4u*)k)[c];
        z += q[8 * c + 0] * __builtin_bit_cast(float, w.x << 16) + q[8 * c + 1] * __builtin_bit_cast(float, w.x & 0xffff0000u);
        z += q[8 * c + 2] * __builtin_bit_cast(float, w.y << 16) + q[8 * c + 3] * __builtin_bit_cast(float, w.y & 0xffff0000u);
        z += q[8 * c + 4] * __builtin_bit_cast(float, w.z << 16) + q[8 * c + 5] * __builtin_bit_cast(float, w.z & 0xffff0000u);
        z += q[8 * c + 6] * __builtin_bit_cast(float, w.w << 16) + q[8 * c + 7] * __builtin_bit_cast(float, w.w & 0xffff0000u); }
    return z;
}
__device__ __forceinline__ void p_attnA_naive(const Ctx& c, const bf16* QKV, float* Fo) {
    const int lane = c.lane; LAS float* qs = (LAS float*)(c.lds + RING_OFF) + c.wave * 64;
    for (int item = c.gw; item < M * NH; item += c.NGW) {
        const int bh = item / SEQ, t = (item + bh * 997) % SEQ, h = bh % NH, b = bh / NH;
        const bf16* qrow = QKV + (size_t)(b * SEQ + t) * NQKV + h * HD;
        const bf16* kb = QKV + (size_t)(b * SEQ) * NQKV + 512 + h * HD;
        const bf16* vb = QKV + (size_t)(b * SEQ) * NQKV + 1024 + h * HD;
        qs[lane] = bf2f(qrow[lane]);
        asm volatile("s_waitcnt lgkmcnt(0)" ::: "memory");
        float o = 0.f, carry = 0.f;
        for (int s0 = t - 1; s0 >= 0; s0 -= 64) {
            const int s = s0 - lane; const bool valid = s >= 0;
            float z = 0.f; if (valid) z = dot64(qs, kb + (size_t)s * NQKV) * 0.125f;
            const float lf = valid ? -softplusf(z) : 0.f;
            float incl = lf;
#pragma unroll
            for (int off = 1; off < 64; off <<= 1) { const float nb = __shfl_up(incl, off); if (lane >= off) incl += nb; }
            const float later = carry + incl - lf;
            const float wgt = valid ? expf(-softplusf(-z) + later) : 0.f;
            carry += __shfl(incl, 63);
            const int nj = s0 + 1 < 64 ? s0 + 1 : 64;
            for (int j = 0; j < nj; ++j) { const float aj = __shfl(wgt, j); o += aj * bf2f(vb[(size_t)(s0 - j) * NQKV + lane]); }
        }
        Fo[(size_t)(b * SEQ + t) * D + h * HD + lane] = o;
        asm volatile("s_waitcnt lgkmcnt(0)" ::: "memory");
    }
}
__device__ __forceinline__ void p_attnB_naive(const Ctx& c, const bf16* QKV, const float* relb, float* Fo) {
    const int lane = c.lane; LAS float* qs = (LAS float*)(c.lds + RING_OFF) + c.wave * 64;
    for (int item = c.gw; item < M * NH; item += c.NGW) {
        const int bh = item / SEQ, t = (item + bh * 997) % SEQ, h = bh % NH, b = bh / NH;
        const bf16* qrow = QKV + (size_t)(b * SEQ + t) * NQKV + 1536 + h * HD;
        const bf16* kb = QKV + (size_t)(b * SEQ) * NQKV + 2048 + h * HD;
        const bf16* vb = QKV + (size_t)(b * SEQ) * NQKV + 2560 + h * HD;
        const float* rb = relb + h * 257;
        qs[lane] = bf2f(qrow[lane]);
        asm volatile("s_waitcnt lgkmcnt(0)" ::: "memory");
        const int ch = t / 64, c0 = ch >= 8 ? ch - 8 : 0, nch = ch - c0 + 1, kstart = c0 * 64;
        float z[9]; float mx = -3.0e38f;
#pragma unroll
        for (int i = 0; i < 9; ++i) { z[i] = -3.0e38f; if (i < nch) { const int s = kstart + 64 * i + lane; int d = t - s; d = d < -128 ? -128 : (d > 128 ? 128 : d);
            z[i] = dot64(qs, kb + (size_t)s * NQKV) * 0.125f + rb[d + 128]; mx = fmaxf(mx, z[i]); } }
        mx = wave_max(mx); float sum = 0.f;
#pragma unroll
        for (int i = 0; i < 9; ++i) { z[i] = i < nch ? expf(z[i] - mx) : 0.f; sum += z[i]; }
        sum = wave_sum(sum); float o = 0.f;
#pragma unroll
        for (int i = 0; i < 9; ++i) if (i < nch) { for (int j = 0; j < 64; ++j) { const float pj = __shfl(z[i], j); o += pj * bf2f(vb[(size_t)(kstart + 64 * i + j) * NQKV + lane]); } }
        Fo[(size_t)(b * SEQ + t) * D + 512 + h * HD + lane] = o / sum;
        asm volatile("s_waitcnt lgkmcnt(0)" ::: "memory");
    }
}

__global__ void __launch_bounds__(NWAVES * 64, 2) fwd_megakernel(Args args) {
    extern __shared__ __attribute__((aligned(16))) unsigned char lds[];
    Ctx c; c.lds = (LAS unsigned char*)lds; c.tid = threadIdx.x; c.lane = c.tid & 63; c.wave = __builtin_amdgcn_readfirstlane(c.tid >> 6);
    const int G = gridDim.x, bx = blockIdx.x; const int vcu = (G % 8 == 0) ? (bx % 8) * (G / 8) + bx / 8 : bx;
    c.gw = vcu * NWAVES + c.wave; c.NGW = G * NWAVES;
    volatile LAS unsigned* MISC = (volatile LAS unsigned*)(c.lds + MISC_OFF);
    unsigned char* ws = args.ws; const float* const* in = args.in; float* out = args.out;
    for (int u = c.tid; u < (LDS_BYTES - LDSCTL_OFF) / 4; u += NWAVES * 64) ((LAS unsigned*)(c.lds + LDSCTL_OFF))[u] = 0u;
    __syncthreads();
    XcdBarrier bar = xcd_barrier_post((unsigned*)(ws + WS_CTL) + CW_BAR, MISC + 8);
    bf16* XN = (bf16*)(ws + WS_XN); bf16* BIG = (bf16*)(ws + WS_BIG); float* F = (float*)(ws + WS_F); bf16* Pb = (bf16*)(ws + WS_P);
    LAS unsigned char* ring = c.lds + RING_OFF;
#define GRID_BAR() xcd_barrier(bar)
#define GEMM(EPI, OUTT, Aptr, Bptr, outp, N_, K_, ld_) do { pg8::Gemm g{Aptr, Bptr, M, N_, K_}; pg8::StaticOrder S; S.init(M, N_, G, bx); pg8::EPI E{(OUTT*)(outp), ld_}; \
        pg8::gemm_phase<pg8::EPI, pg8::StaticOrder, true, true>(ring, g, S, E); } while (0)

    p_prologue(args, c); GRID_BAR();
    GEMM(EpiSwiGLU, bf16, XN, (const bf16*)(ws + WS_W1GU), BIG, 2 * FF, D, FF); GRID_BAR();
    GEMM(EpiF32, float, BIG, (const bf16*)(ws + WS_W1D), F, D, FF, D); GRID_BAR();
    p_post(c, F, in[0], out, in[3], in[7], XN, 0.5f, 1); GRID_BAR();
    GEMM(EpiBf16, bf16, XN, (const bf16*)(ws + WS_WIN), BIG, NQKV, D, NQKV); GRID_BAR();
    p_attnA_naive(c, BIG, F); p_attnB_naive(c, BIG, in[12], F); GRID_BAR();
    p_onorm(c, F, in[10], in[11], XN); GRID_BAR();
    GEMM(EpiF32, float, XN, (const bf16*)(ws + WS_WOUT), F, D, D, D); GRID_BAR();
    p_post(c, F, out, out, in[8], in[14], XN, 1.0f, 1); GRID_BAR();
    GEMM(EpiSwiGLU, bf16, XN, (const bf16*)(ws + WS_W2GU), BIG, 2 * FF, D, FF); GRID_BAR();
    GEMM(EpiF32, float, BIG, (const bf16*)(ws + WS_W2D), F, D, FF, D); GRID_BAR();
    p_post(c, F, out, out, in[15], in[15], XN, 0.5f, 2); GRID_BAR();
    GEMM(EpiBf16, bf16, Pb, (const bf16*)(ws + WS_WP), BIG, D, PLE, D);
    GEMM(EpiF32, float, XN, (const bf16*)(ws + WS_WG), F, D, D, D); GRID_BAR();
    p_final(c, F, BIG, out, in[21], out);
}

extern "C" void kernel_launch(void* const* d_in, const int* in_sizes, int n_in, void* d_out, int out_size, void* d_ws, size_t ws_size, hipStream_t stream) {
    static int grid = 0;
    if (grid == 0) {
        if (n_in != 22 || in_sizes[0] != M * D || out_size != M * D || ws_size < WS_END) { fprintf(stderr, "kernel_launch: unexpected shapes n_in %d in0 %d out %d ws %zu\n", n_in, n_in > 0 ? in_sizes[0] : -1, out_size, ws_size); grid = -1; return; }
        int dev = 0, cus = 0, per_cu = 0;
        if (hipGetDevice(&dev) != hipSuccess || hipDeviceGetAttribute(&cus, hipDeviceAttributeMultiprocessorCount, dev) != hipSuccess) { fprintf(stderr, "kernel_launch: device query failed\n"); grid = -1; return; }
        if (hipFuncSetAttribute((const void*)fwd_megakernel, hipFuncAttributeMaxDynamicSharedMemorySize, LDS_BYTES) != hipSuccess) { fprintf(stderr, "kernel_launch: hipFuncSetAttribute failed\n"); grid = -1; return; }
        if (hipOccupancyMaxActiveBlocksPerMultiprocessor(&per_cu, (const void*)fwd_megakernel, NWAVES * 64, LDS_BYTES) != hipSuccess || per_cu < 1) { fprintf(stderr, "kernel_launch: occupancy query says %d blocks per CU\n", per_cu); (void)hipGetLastError(); grid = -1; return; }
        grid = cus;
        if (grid != 256) fprintf(stderr, "kernel_launch: note: %d CUs\n", grid);
    }
    if (grid < 0) return;
    if (hipMemsetAsync((char*)d_ws + WS_CTL, 0, CTL_ZERO_BYTES, stream) != hipSuccess) { fprintf(stderr, "kernel_launch: memset failed\n"); return; }
    Args a{}; for (int i = 0; i < 22; ++i) a.in[i] = (const float*)d_in[i]; a.out = (float*)d_out; a.ws = (unsigned char*)d_ws;
    void* kargs[] = {&a};
    const hipError_t e = hipLaunchCooperativeKernel((const void*)fwd_megakernel, dim3(grid), dim3(NWAVES * 64), kargs, LDS_BYTES, stream);
    if (e != hipSuccess) fprintf(stderr, "kernel_launch: cooperative launch failed: %s (grid %d)\n", hipGetErrorString(e), grid);
}
```

```cpp
#include <hip/hip_runtime.h>
#include <cstdio>
#include <cstdint>
namespace pg8 {
#define PG8_LAS __attribute__((address_space(3)))
typedef unsigned short bf16_t;
typedef short bf16x8 __attribute__((ext_vector_type(8)));
typedef float f32x4 __attribute__((ext_vector_type(4)));
typedef unsigned u32x4 __attribute__((ext_vector_type(4)));
constexpr int BM = 256, BK = 64, HALF = 128, HTB = HALF * BK * 2  , STAGE_BYTES = 8 * HTB, NXCD = 8, WGM = 8;

__host__ __device__ __forceinline__ int lds_byte(int r, int c) { const int st = (r >> 4) * 2 + (c >> 5), rr = r & 15, cc = c & 31, ob = rr * 64 + cc * 2; return st * 1024 + (ob ^ (((ob >> 9) & 1) << 5)); }
__host__ __device__ __forceinline__ void stage_rc(int b, int& R, int& C) { const int st = b / 1024, sb = b % 1024, swz = sb ^ (((sb >> 9) & 1) << 5); R = (st >> 1) * 16 + swz / 64; C = (st & 1) * 32 + (swz % 64) / 2; }
__host__ __device__ __forceinline__ int perm32(int rho) { const int n = rho >> 4, i = rho & 15; return 8 * (i >> 2) + 4 * n + (i & 3); }

struct Unit { int pm, pn; };
struct Gemm { const bf16_t* A; const bf16_t* Bt; int M, N, K; };

struct StaticOrder {
    int nM, nN, nwg, G, c;
    __host__ __device__ void init(int M, int N, int G_, int c_) { nM = M / BM; nN = N / BM; nwg = nM * nN; G = G_; c = c_; }
    __host__ __device__ bool next(int i, Unit& u) const {
        const long L = (long)i * G + c; if (L >= nwg) return false;
        int wgid = (int)L; { const int q = nwg / NXCD, r = nwg % NXCD, xcd = wgid % NXCD, off = wgid / NXCD; wgid = (xcd < r ? xcd * (q + 1) : r * (q + 1) + (xcd - r) * q) + off; }
        const int nig = WGM * nN, gid = wgid / nig, fm = gid * WGM, gsz = (nM - fm) < WGM ? (nM - fm) : WGM;
        u.pm = fm + ((wgid % nig) % gsz); u.pn = (wgid % nig) / gsz; return true;
    }
    __device__ __forceinline__ void a_ready(const Unit&) const {}
    __device__ __forceinline__ void done(const Unit&) const {}
};

__device__ __forceinline__ unsigned cvt_pk_bf16(float lo, float hi) { unsigned r; asm volatile("v_cvt_pk_bf16_f32 %0, %1, %2" : "=v"(r) : "v"(lo), "v"(hi)); return r; }

struct EpiF32 {
    static constexpr bool PERM = false, AFTER_DRAIN = false;
    float* F; int ldc;
    __device__ __forceinline__ void operator()(const f32x4 (&acc)[2][2][4][2], const Unit& u, int wr, int wc, int fr, int fq) const {
        const int row0 = u.pm * BM + wr * 64 + fr, col0 = u.pn * BM + wc * 32 + 4 * fq;
#pragma unroll
        for (int ai = 0; ai < 2; ++ai)
#pragma unroll
            for (int m = 0; m < 4; ++m) { float* rowp = F + (size_t)(row0 + ai * HALF + m * 16) * ldc + col0;
#pragma unroll
                for (int bj = 0; bj < 2; ++bj)
#pragma unroll
                    for (int n = 0; n < 2; ++n) *(f32x4*)(rowp + bj * HALF + n * 16) = acc[ai][bj][m][n]; }
    }
};
struct EpiBf16 {
    static constexpr bool PERM = true, AFTER_DRAIN = false;
    bf16_t* O; int ldc;
    __device__ __forceinline__ void operator()(const f32x4 (&acc)[2][2][4][2], const Unit& u, int wr, int wc, int fr, int fq) const {
        const int row0 = u.pm * BM + wr * 64 + fr, col0 = u.pn * BM + wc * 32 + 8 * fq;
#pragma unroll
        for (int ai = 0; ai < 2; ++ai)
#pragma unroll
            for (int m = 0; m < 4; ++m) { bf16_t* rowp = O + (size_t)(row0 + ai * HALF + m * 16) * ldc + col0;
#pragma unroll
                for (int bj = 0; bj < 2; ++bj) { const f32x4 v0 = acc[ai][bj][m][0], v1 = acc[ai][bj][m][1];
                    u32x4 w; w.x = cvt_pk_bf16(v0[0], v0[1]); w.y = cvt_pk_bf16(v0[2], v0[3]); w.z = cvt_pk_bf16(v1[0], v1[1]); w.w = cvt_pk_bf16(v1[2], v1[3]);
                    *(u32x4*)(rowp + bj * HALF) = w; } }
    }
};
__device__ __forceinline__ float silu_mul(float g, float u) { return g * u * __builtin_amdgcn_rcpf(1.0f + __expf(-g)); }
struct EpiSwiGLU {
    static constexpr bool PERM = true, AFTER_DRAIN = false;
    bf16_t* H; int ldh;
    __device__ __forceinline__ void operator()(const f32x4 (&acc)[2][2][4][2], const Unit& u, int wr, int wc, int fr, int fq) const {
        const int row0 = u.pm * BM + wr * 64 + fr, col0 = u.pn * HALF + wc * 32 + 8 * fq;
#pragma unroll
        for (int ai = 0; ai < 2; ++ai)
#pragma unroll
            for (int m = 0; m < 4; ++m) { bf16_t* rowp = H + (size_t)(row0 + ai * HALF + m * 16) * ldh + col0;
                const f32x4 g0 = acc[ai][0][m][0], g1 = acc[ai][0][m][1], u0 = acc[ai][1][m][0], u1 = acc[ai][1][m][1];
                u32x4 w; w.x = cvt_pk_bf16(silu_mul(g0[0], u0[0]), silu_mul(g0[1], u0[1])); w.y = cvt_pk_bf16(silu_mul(g0[2], u0[2]), silu_mul(g0[3], u0[3]));
                w.z = cvt_pk_bf16(silu_mul(g1[0], u1[0]), silu_mul(g1[1], u1[1])); w.w = cvt_pk_bf16(silu_mul(g1[2], u1[2]), silu_mul(g1[3], u1[3]));
                *(u32x4*)rowp = w; }
    }
};

template <class Epi, class Sched, bool ALIGN_EPI = false, bool SP2 = false>
__device__ __forceinline__ void gemm_phase(PG8_LAS unsigned char* lds, const Gemm g, const Sched& S, const Epi& E) {
    int tid_ = threadIdx.x; asm volatile("" : "+v"(tid_));
    const int tid = tid_, wid = __builtin_amdgcn_readfirstlane(tid >> 6), lane = tid & 63, wr = wid >> 2, wc = wid & 3, fr = lane & 15, fq = lane >> 4;
    const int K = g.K, nt = K / BK;
    unsigned voffA[2], voffB[2];
#pragma unroll
    for (int i = 0; i < 2; ++i) { int R, C; stage_rc(tid * 16 + i * 8192, R, C); const int Rb = Epi::PERM ? ((R & ~31) + perm32(R & 31)) : R;
        voffA[i] = (unsigned)(R * K + C) * 2u; voffB[i] = (unsigned)(Rb * K + C) * 2u; }
    const size_t kstep = (size_t)(BK * 2);
    const size_t hstep = (size_t)HALF * K * 2;
    const size_t tstep = 2 * hstep;
    const unsigned ldsw = (unsigned)wid * 1024u;
    const int aoff = lds_byte(wr * 64 + fr, fq * 8), boff = lds_byte(wc * 32 + fr, fq * 8);
#define PG8_SA(b, h) (((b) * 2 + (h)) * HTB)
#define PG8_SB(b, h) ((4 + (b) * 2 + (h)) * HTB)
#define PG8_STAGE(bufoff, gbase, voff) do { _Pragma("unroll") for (int _i = 0; _i < 2; ++_i) \
        __builtin_amdgcn_global_load_lds((const unsigned*)((const char*)(gbase) + (voff)[_i]), (PG8_LAS unsigned*)(lds + (bufoff) + ldsw + _i * 8192), 16, 0, 0); } while (0)
#define PG8_LDA(dst, b, h) do { _Pragma("unroll") for (int m = 0; m < 4; ++m) _Pragma("unroll") for (int k = 0; k < 2; ++k) dst[m][k] = *(const PG8_LAS bf16x8*)(lds + PG8_SA(b, h) + aoff + m * 2048 + k * 1024); } while (0)
#define PG8_LDB(dst, b, h) do { _Pragma("unroll") for (int n = 0; n < 2; ++n) _Pragma("unroll") for (int k = 0; k < 2; ++k) dst[n][k] = *(const PG8_LAS bf16x8*)(lds + PG8_SB(b, h) + boff + n * 2048 + k * 1024); } while (0)
#define PG8_MMA(ai, bj, At, Bt) do { __builtin_amdgcn_s_setprio(1); _Pragma("unroll") for (int m = 0; m < 4; ++m) _Pragma("unroll") for (int n = 0; n < 2; ++n) _Pragma("unroll") for (int k = 0; k < 2; ++k) \
        acc[ai][bj][m][n] = __builtin_amdgcn_mfma_f32_16x16x32_bf16(Bt[n][k], At[m][k], acc[ai][bj][m][n], 0, 0, 0); __builtin_amdgcn_s_setprio(0); } while (0)
#define PG8_WAIT_V(n) asm volatile("s_waitcnt vmcnt(" #n ")" ::: "memory")
#define PG8_WAIT_L(n) asm volatile("s_waitcnt lgkmcnt(" #n ")" ::: "memory")
#define PG8_BAR __builtin_amdgcn_s_barrier()
#define PG8_SCHED __builtin_amdgcn_sched_barrier(0)
    Unit cur, nxt; int ui = 0;
    if (!S.next(0, cur)) return;
    f32x4 acc[2][2][4][2];
#pragma unroll
    for (int a = 0; a < 2; ++a)
#pragma unroll
        for (int b = 0; b < 2; ++b)
#pragma unroll
            for (int m = 0; m < 4; ++m)
#pragma unroll
                for (int n = 0; n < 2; ++n) acc[a][b][m][n] = (f32x4){0.f, 0.f, 0.f, 0.f};
    bf16x8 At[4][2], B0[2][2], B1[2][2];
    const char* cA = (const char*)g.A + (size_t)cur.pm * tstep; const char* cB = (const char*)g.Bt + (size_t)cur.pn * tstep;
    S.a_ready(cur);
    if constexpr (SP2) {
        PG8_STAGE(PG8_SB(0, 0), cB, voffB); PG8_STAGE(PG8_SB(0, 1), cB + hstep, voffB); PG8_STAGE(PG8_SA(0, 0), cA, voffA); PG8_STAGE(PG8_SA(0, 1), cA + hstep, voffA);
        if (wr == 1) PG8_BAR;
        PG8_WAIT_V(2); PG8_BAR;
        PG8_STAGE(PG8_SB(1, 0), cB + kstep, voffB); PG8_STAGE(PG8_SA(1, 0), cA + kstep, voffA); PG8_STAGE(PG8_SB(1, 1), cB + hstep + kstep, voffB);
        PG8_WAIT_V(6); PG8_BAR;
    } else {
        PG8_STAGE(PG8_SB(0, 0), cB, voffB); PG8_STAGE(PG8_SA(0, 0), cA, voffA); PG8_STAGE(PG8_SB(0, 1), cB + hstep, voffB); PG8_STAGE(PG8_SA(0, 1), cA + hstep, voffA);
        if (wr == 1) PG8_BAR;
        PG8_WAIT_V(4); PG8_BAR;
        PG8_STAGE(PG8_SB(1, 0), cB + kstep, voffB); PG8_STAGE(PG8_SA(1, 0), cA + kstep, voffA); PG8_STAGE(PG8_SB(1, 1), cB + hstep + kstep, voffB);
        PG8_WAIT_V(6); PG8_BAR;
    }
    for (;;) {
        const bool has_next = S.next(ui + 1, nxt);
        const char* nA = has_next ? (const char*)g.A + (size_t)nxt.pm * tstep : cA; const char* nB = has_next ? (const char*)g.Bt + (size_t)nxt.pn * tstep : cB;
        for (int t = 0; t < nt; t += 2) {
            const bool last = (t == nt - 2);
            const char* a1 = cA + (size_t)(t + 1) * kstep;
            const char* a2 = last ? nA : cA + (size_t)(t + 2) * kstep; const char* b2 = last ? nB : cB + (size_t)(t + 2) * kstep;
            const char* a3 = a2 + kstep; const char* b3 = b2 + kstep;
            if (last && has_next) S.a_ready(nxt);
            if constexpr (SP2) {
            PG8_LDB(B0, 0, 0); PG8_LDB(B1, 0, 1); PG8_SCHED; PG8_LDA(At, 0, 0); PG8_STAGE(PG8_SA(1, 1), a1 + hstep, voffA);
            PG8_WAIT_V(8); PG8_WAIT_L(0); PG8_BAR; PG8_MMA(0, 0, At, B0); PG8_MMA(0, 1, At, B1); PG8_BAR; PG8_SCHED;
            PG8_LDA(At, 0, 1); PG8_STAGE(PG8_SB(0, 0), b2, voffB); PG8_STAGE(PG8_SB(0, 1), b2 + hstep, voffB); PG8_STAGE(PG8_SA(0, 0), a2, voffA);
            PG8_WAIT_V(8); PG8_WAIT_L(0); PG8_BAR; PG8_MMA(1, 0, At, B0); PG8_MMA(1, 1, At, B1); PG8_BAR; PG8_SCHED;
            PG8_LDB(B0, 1, 0); PG8_LDB(B1, 1, 1); PG8_SCHED; PG8_LDA(At, 1, 0); PG8_STAGE(PG8_SA(0, 1), a2 + hstep, voffA);
            PG8_WAIT_V(8); PG8_WAIT_L(0); PG8_BAR; PG8_MMA(0, 0, At, B0); PG8_MMA(0, 1, At, B1); PG8_BAR; PG8_SCHED;
            PG8_LDA(At, 1, 1); PG8_STAGE(PG8_SB(1, 0), b3, voffB); PG8_STAGE(PG8_SB(1, 1), b3 + hstep, voffB); PG8_STAGE(PG8_SA(1, 0), a3, voffA);
            PG8_WAIT_V(8); PG8_WAIT_L(0); PG8_BAR; PG8_MMA(1, 0, At, B0); PG8_MMA(1, 1, At, B1); PG8_BAR; PG8_SCHED;
            } else {
            PG8_LDB(B0, 0, 0); PG8_SCHED; PG8_LDA(At, 0, 0); PG8_STAGE(PG8_SA(1, 1), a1 + hstep, voffA);
            PG8_WAIT_L(8); PG8_BAR; PG8_WAIT_L(0); PG8_MMA(0, 0, At, B0); PG8_BAR; PG8_SCHED;
            PG8_LDB(B1, 0, 1); PG8_STAGE(PG8_SB(0, 0), b2, voffB);
            PG8_BAR; PG8_WAIT_L(0); PG8_MMA(0, 1, At, B1); PG8_BAR;
            PG8_LDA(At, 0, 1); PG8_STAGE(PG8_SA(0, 0), a2, voffA);
            PG8_BAR; PG8_WAIT_L(0); PG8_MMA(1, 0, At, B0); PG8_BAR; PG8_SCHED;
            PG8_STAGE(PG8_SB(0, 1), b2 + hstep, voffB);
            PG8_WAIT_V(6); PG8_BAR; PG8_MMA(1, 1, At, B1); PG8_BAR;
            PG8_LDB(B0, 1, 0); PG8_SCHED; PG8_LDA(At, 1, 0); PG8_STAGE(PG8_SA(0, 1), a2 + hstep, voffA);
            PG8_WAIT_L(8); PG8_BAR; PG8_WAIT_L(0); PG8_MMA(0, 0, At, B0); PG8_BAR; PG8_SCHED;
            PG8_LDB(B1, 1, 1); PG8_STAGE(PG8_SB(1, 0), b3, voffB);
            PG8_BAR; PG8_WAIT_L(0); PG8_MMA(0, 1, At, B1); PG8_BAR;
            PG8_LDA(At, 1, 1); PG8_STAGE(PG8_SA(1, 0), a3, voffA);
            PG8_BAR; PG8_WAIT_L(0); PG8_MMA(1, 0, At, B0); PG8_BAR; PG8_SCHED;
            PG8_STAGE(PG8_SB(1, 1), b3 + hstep, voffB);
            PG8_WAIT_V(6); PG8_BAR; PG8_MMA(1, 1, At, B1); PG8_BAR;
            }
        }
        if constexpr (ALIGN_EPI) { if (wr == 0) PG8_BAR; }
        if constexpr (!Epi::AFTER_DRAIN) { E(acc, cur, wr, wc, fr, fq); S.done(cur); }
        if (!has_next) break;
#pragma unroll
        for (int a = 0; a < 2; ++a)
#pragma unroll
            for (int b = 0; b < 2; ++b)
#pragma unroll
                for (int m = 0; m < 4; ++m)
#pragma unroll
                    for (int n = 0; n < 2; ++n) acc[a][b][m][n] = (f32x4){0.f, 0.f, 0.f, 0.f};
        cur = nxt; cA = nA; cB = nB; ++ui;
        if constexpr (ALIGN_EPI) { if (wr == 1) PG8_BAR; }
    }
    PG8_WAIT_V(0);
    if constexpr (!ALIGN_EPI) { if (wr == 0) PG8_BAR; }
    PG8_BAR;
    if constexpr (Epi::AFTER_DRAIN) { E.fused(acc, cur, wr, wc, fr, fq, lds, wid, lane); S.done(cur); }
#undef PG8_SA
#undef PG8_SB
#undef PG8_STAGE
#undef PG8_LDA
#undef PG8_LDB
#undef PG8_MMA
#undef PG8_WAIT_V
#undef PG8_WAIT_L
#undef PG8_BAR
#undef PG8_SCHED
}
}
constexpr int BATCH = 8, SEQ = 2048, D = 1024, FF = 2816, HD = 64, NH = 8, PLE = 256, NQKV = 3072;
constexpr int M = BATCH * SEQ;
constexpr float EPS = 1e-6f;
typedef unsigned short bf16;
typedef float f32x4 __attribute__((ext_vector_type(4)));
typedef unsigned v4u __attribute__((ext_vector_type(4)));
typedef unsigned v2u __attribute__((ext_vector_type(2)));
#define LAS __attribute__((address_space(3)))

constexpr size_t MiB = 1u << 20;
constexpr size_t WS_CTL = 0, CTL_ZERO_BYTES = 1 * MiB;
constexpr int CW_BAR = 4096;
constexpr size_t WS_W1GU = 1 * MiB;
constexpr size_t WS_W1D  = 12 * MiB;
constexpr size_t WS_WQK  = 18 * MiB;
constexpr size_t WS_WV   = 22 * MiB;
constexpr size_t WS_WOUT = 24 * MiB;
constexpr size_t WS_W2GU = 26 * MiB;
constexpr size_t WS_W2D  = 37 * MiB;
constexpr size_t WS_WP   = 43 * MiB;
constexpr size_t WS_WG   = 44 * MiB;
constexpr size_t WS_P    = 46 * MiB;
constexpr size_t WS_XN   = 54 * MiB;
constexpr size_t WS_BIG  = 86 * MiB;
constexpr size_t WS_VT   = WS_BIG + 64 * MiB;
constexpr size_t WS_F    = 182 * MiB;
constexpr size_t WS_END  = 246 * MiB;

__device__ __forceinline__ unsigned f2bf(float f) { unsigned u = __builtin_bit_cast(unsigned, f); return (u + 0x7fffu + ((u >> 16) & 1u)) >> 16; }
__device__ __forceinline__ unsigned pk2(float lo, float hi) { return f2bf(lo) | (f2bf(hi) << 16); }
__device__ __forceinline__ float bf2f(bf16 b) { return __builtin_bit_cast(float, (unsigned)b << 16); }
__device__ __forceinline__ float wave_sum(float v) {
#pragma unroll
    for (int o = 1; o < 64; o <<= 1) v += __shfl_xor(v, o);
    return v;
}
__device__ __forceinline__ float wave_max(float v) {
#pragma unroll
    for (int o = 1; o < 64; o <<= 1) v = fmaxf(v, __shfl_xor(v, o));
    return v;
}

__device__ __forceinline__ void transpose_item(const float* W, int K, int N, bf16* WT, int k0, int n0, int rowbase, LAS float* scr, int lane, float sc = 1.0f) {
#pragma unroll 8
    for (int i = 0; i < 32; ++i) { const int kk = 2 * i + (lane >> 5); scr[kk * 33 + (lane & 31)] = sc * W[(size_t)(k0 + kk) * N + n0 + (lane & 31)]; }
    asm volatile("s_waitcnt lgkmcnt(0)" ::: "memory");
    const int c = lane & 7;
#pragma unroll
    for (int j = 0; j < 4; ++j) { const int n = (lane >> 3) + 8 * j; const LAS float* s = scr + (8 * c) * 33 + n;
        v4u o; o.x = pk2(s[0 * 33], s[1 * 33]); o.y = pk2(s[2 * 33], s[3 * 33]); o.z = pk2(s[4 * 33], s[5 * 33]); o.w = pk2(s[6 * 33], s[7 * 33]);
        *(v4u*)(WT + (size_t)(rowbase + n) * K + k0 + 8 * c) = o; }
    asm volatile("s_waitcnt lgkmcnt(0)" ::: "memory");
}
__device__ __forceinline__ void transpose_matrix_item(const float* W, int K, int N, bf16* WT, int mode, LAS float* scr, int item, int lane) {
    const int nblk = N / 32, kb = item / nblk, nb = item % nblk, k0 = 64 * kb, n0 = 32 * nb;
    const int rowbase = mode == 0 ? n0 : (256 * (n0 / 128) + (n0 % 128) + (mode == 2 ? 128 : 0));
    transpose_item(W, K, N, WT, k0, n0, rowbase, scr, lane);
}
__device__ __forceinline__ void transpose_win_item(const float* W, bf16* WQK, bf16* WV, LAS float* scr, int item, int lane) {
    const int nblk = NQKV / 32, kb = item / nblk, nb = item % nblk, k0 = 64 * kb, n0 = 32 * nb, seg = n0 / 512, within = n0 % 512;
    const bool isv = (seg == 2 || seg == 5), isq = (seg == 0 || seg == 3);
    const int rowbase = isv ? (seg == 2 ? 0 : 512) + within : (seg < 2 ? seg : seg - 1) * 512 + within;
    transpose_item(W, D, NQKV, isv ? WV : WQK, k0, n0, rowbase, scr, lane, isq ? 0.125f * 1.4426950408889634f : 1.0f);
}

#define GAS __attribute__((address_space(1)))
typedef GAS unsigned gu32;
#define RLX_AGENT __ATOMIC_RELAXED, __HIP_MEMORY_SCOPE_AGENT
constexpr int RING_OFF = 0, RING_BYTES = 131072;
constexpr int XTRA_OFF = RING_BYTES, XTRA_BYTES = 16384;
constexpr int LDSCTL_OFF = XTRA_OFF + XTRA_BYTES, MISC_OFF = LDSCTL_OFF + 320;
constexpr int LDS_BYTES = LDSCTL_OFF + 1024;
constexpr int NWAVES = 8;
#define XB_TMO      128
#define XB_XCNT(j)  (256  + 64 * (j))
#define XB_XSUB(j)  (1280 + 64 * (j))
#define XB_XGEN(j)  (2304 + 64 * (j))
#define XB_TOP      3328
#define XB_TOPGEN   3392
#define XCD_BAR_WORDS 3456
#define XB_SPIN_CAP (1u << 18)

__device__ __forceinline__ unsigned xb_ld(unsigned* p)              { return __hip_atomic_load(p, __ATOMIC_RELAXED, __HIP_MEMORY_SCOPE_AGENT); }
__device__ __forceinline__ unsigned xb_add(unsigned* p, unsigned v) { return __hip_atomic_fetch_add(p, v, __ATOMIC_RELAXED, __HIP_MEMORY_SCOPE_AGENT); }
__device__ __forceinline__ unsigned xb_xcc_id() { return (unsigned)__builtin_amdgcn_s_getreg((3 << 11) | 20) & 0xFu; }
#define XB_SPIN(cond, bar) do { unsigned _sp = 0; while (cond) { __builtin_amdgcn_s_sleep(1); \
    if ((++_sp & 255u) == 0u) { if (xb_ld(&(bar)[XB_TMO])) break; if (_sp > XB_SPIN_CAP) { atomicAdd(&(bar)[XB_TMO], 1u); break; } } } } while (0)

struct XcdBarrier {
    unsigned* bar; unsigned x;
    volatile LAS unsigned* st;
};

__device__ __forceinline__ XcdBarrier xcd_barrier_post(unsigned* bar, volatile LAS unsigned* st) {
    XcdBarrier b; b.bar = bar; b.x = xb_xcc_id(); b.st = st;
    if (threadIdx.x == 0) (void)xb_add(&bar[XB_XCNT(b.x)], 1u);
    return b;
}
__device__ __forceinline__ void xcd_barrier_complete(unsigned* bar, unsigned x, unsigned& nloc, unsigned& nx) {
    const unsigned G = gridDim.x * gridDim.y * gridDim.z;
    unsigned sum, cnt, mine, sp = 0u;
    for (;;) {
        sum = 0u; cnt = 0u; mine = 0u;
#pragma unroll
        for (unsigned j = 0; j < 16; ++j) { const unsigned c = xb_ld(&bar[XB_XCNT(j)]); sum += c; cnt += (c > 0u) ? 1u : 0u; mine = (j == x) ? c : mine; }
        if (sum == G) break;
        __builtin_amdgcn_s_sleep(1);
        if ((++sp & 255u) == 0u) { if (xb_ld(&bar[XB_TMO])) break; if (sp > XB_SPIN_CAP) { atomicAdd(&bar[XB_TMO], 1u); break; } }
    }
    nloc = mine > 0u ? mine : 1u; nx = cnt > 0u ? cnt : 1u;
}

__device__ __forceinline__ void xcd_barrier(const XcdBarrier& b) {
    asm volatile("s_waitcnt vmcnt(0)" ::: "memory");
    __syncthreads();
    if (threadIdx.x == 0) {
        unsigned* bar = b.bar;
        __builtin_amdgcn_s_waitcnt(0);
        unsigned nloc = b.st[0], nx = b.st[1];
        if (nloc == 0u) { xcd_barrier_complete(bar, b.x, nloc, nx); b.st[0] = nloc; b.st[1] = nx; }
        const unsigned old = xb_add(&bar[XB_XSUB(b.x)], 1u);
        const unsigned gen = old / nloc;
        if (old + 1u == (gen + 1u) * nloc) {
            __builtin_amdgcn_fence(__ATOMIC_RELEASE, "agent");
            asm volatile("s_waitcnt vmcnt(0)" ::: "memory");
            const unsigned og = xb_add(&bar[XB_TOP], 1u);
            const unsigned tg = og / nx;
            if (og + 1u == (tg + 1u) * nx) xb_add(&bar[XB_TOPGEN], 1u);
            else XB_SPIN(xb_ld(&bar[XB_TOPGEN]) == tg, bar);
            __builtin_amdgcn_fence(__ATOMIC_ACQUIRE, "agent");
            xb_add(&bar[XB_XGEN(b.x)], 1u);
            asm volatile("s_waitcnt vmcnt(0)" ::: "memory");
        } else {
            XB_SPIN(xb_ld(&bar[XB_XGEN(b.x)]) == gen, bar);
            __builtin_amdgcn_fence(__ATOMIC_ACQUIRE, "agent");
            asm volatile("s_waitcnt vmcnt(0)" ::: "memory");
        }
    }
    __syncthreads();
}


struct Args { const float* in[22]; float* out; unsigned char* ws; };
struct Ctx { LAS unsigned char* lds; int tid, lane, wave, gw, NGW; };

__device__ __forceinline__ void p_prologue(const Args& a, const Ctx& c) {
    LAS float* scr = (LAS float*)(c.lds + RING_OFF + c.wave * 16384);
    const int lane = c.lane, gw = c.gw, NGW = c.NGW; unsigned char* ws = a.ws;
    constexpr int I_GU = (D / 64) * (FF / 32), I_DN = (FF / 64) * (D / 32), I_IN = (D / 64) * (NQKV / 32), I_SQ = (D / 64) * (D / 32), I_P = (PLE / 64) * (D / 32);
    constexpr int NITEMS = 4 * I_GU + 2 * I_DN + I_IN + 2 * I_SQ + I_P;
    for (int it = gw; it < NITEMS; it += NGW) {
        int r = it;
        if (r < I_GU) { transpose_matrix_item(a.in[4], D, FF, (bf16*)(ws + WS_W1GU), 1, scr, r, lane); continue; } r -= I_GU;
        if (r < I_GU) { transpose_matrix_item(a.in[5], D, FF, (bf16*)(ws + WS_W1GU), 2, scr, r, lane); continue; } r -= I_GU;
        if (r < I_DN) { transpose_matrix_item(a.in[6], FF, D, (bf16*)(ws + WS_W1D), 0, scr, r, lane); continue; } r -= I_DN;
        if (r < I_IN) { transpose_win_item(a.in[9], (bf16*)(ws + WS_WQK), (bf16*)(ws + WS_WV), scr, r, lane); continue; } r -= I_IN;
        if (r < I_SQ) { transpose_matrix_item(a.in[13], D, D, (bf16*)(ws + WS_WOUT), 0, scr, r, lane); continue; } r -= I_SQ;
        if (r < I_GU) { transpose_matrix_item(a.in[16], D, FF, (bf16*)(ws + WS_W2GU), 1, scr, r, lane); continue; } r -= I_GU;
        if (r < I_GU) { transpose_matrix_item(a.in[17], D, FF, (bf16*)(ws + WS_W2GU), 2, scr, r, lane); continue; } r -= I_GU;
        if (r < I_DN) { transpose_matrix_item(a.in[18], FF, D, (bf16*)(ws + WS_W2D), 0, scr, r, lane); continue; } r -= I_DN;
        if (r < I_P)  { transpose_matrix_item(a.in[19], PLE, D, (bf16*)(ws + WS_WP), 0, scr, r, lane); continue; } r -= I_P;
        transpose_matrix_item(a.in[20], D, D, (bf16*)(ws + WS_WG), 0, scr, r, lane);
    }
    const float* x = a.in[0]; const float* g = a.in[2]; bf16* XN = (bf16*)(ws + WS_XN);
    for (int m = gw; m < M; m += NGW) {
        const f32x4* xr = (const f32x4*)(x + (size_t)m * D) + lane; f32x4 v[4]; float s = 0.f;
#pragma unroll
        for (int j = 0; j < 4; ++j) { v[j] = xr[64 * j]; s += (v[j].x * v[j].x + v[j].y * v[j].y) + (v[j].z * v[j].z + v[j].w * v[j].w); }
        const float rstd = 1.0f / sqrtf(wave_sum(s) * (1.f / D) + EPS);
        v2u* o8 = (v2u*)(XN + (size_t)m * D) + lane;
#pragma unroll
        for (int j = 0; j < 4; ++j) { const f32x4 gg = ((const f32x4*)g)[lane + 64 * j]; v2u w; w.x = pk2(v[j].x * rstd * gg.x, v[j].y * rstd * gg.y); w.y = pk2(v[j].z * rstd * gg.z, v[j].w * rstd * gg.w); o8[64 * j] = w; }
    }
    const float* p = a.in[1]; bf16* Pb = (bf16*)(ws + WS_P);
    for (int m = gw; m < M; m += NGW) { const f32x4 v = ((const f32x4*)(p + (size_t)m * PLE))[lane]; v2u w; w.x = pk2(v.x, v.y); w.y = pk2(v.z, v.w); ((v2u*)(Pb + (size_t)m * PLE))[lane] = w; }
}

__device__ __forceinline__ void p_post(const Ctx& c, const float* F, const float* hin, float* hout, const float* gpost, const float* gnext, bf16* XN, float scale, int mode) {
    const int lane = c.lane;
    for (int m = c.gw; m < M; m += c.NGW) {
        const f32x4* fr = (const f32x4*)(F + (size_t)m * D) + lane; const f32x4* hr = (const f32x4*)(hin + (size_t)m * D) + lane;
        f32x4 f[4], h[4]; float s = 0.f;
#pragma unroll
        for (int j = 0; j < 4; ++j) { f[j] = fr[64 * j]; h[j] = hr[64 * j]; s += (f[j].x * f[j].x + f[j].y * f[j].y) + (f[j].z * f[j].z + f[j].w * f[j].w); }
        const float r1 = scale / sqrtf(wave_sum(s) * (1.f / D) + EPS); float s2 = 0.f;
#pragma unroll
        for (int j = 0; j < 4; ++j) { const f32x4 g = ((const f32x4*)gpost)[lane + 64 * j]; h[j] = h[j] + f[j] * g * r1; s2 += (h[j].x * h[j].x + h[j].y * h[j].y) + (h[j].z * h[j].z + h[j].w * h[j].w); }
        f32x4* ho = (f32x4*)(hout + (size_t)m * D) + lane;
#pragma unroll
        for (int j = 0; j < 4; ++j) ho[64 * j] = h[j];
        const float r2 = mode == 1 ? 1.0f / sqrtf(wave_sum(s2) * (1.f / D) + EPS) : 1.0f;
        v2u* o8 = (v2u*)(XN + (size_t)m * D) + lane;
#pragma unroll
        for (int j = 0; j < 4; ++j) { f32x4 g = {1.f, 1.f, 1.f, 1.f}; if (mode == 1) g = ((const f32x4*)gnext)[lane + 64 * j];
            v2u w; w.x = pk2(h[j].x * r2 * g.x, h[j].y * r2 * g.y); w.y = pk2(h[j].z * r2 * g.z, h[j].w * r2 * g.w); o8[64 * j] = w; }
    }
}
__device__ __forceinline__ void p_final(const Ctx& c, const float* F, const bf16* PP, const float* h, const float* g, float* out) {
    const int lane = c.lane;
    for (int m = c.gw; m < M; m += c.NGW) {
        const f32x4* fr = (const f32x4*)(F + (size_t)m * D) + lane; const v2u* pr = (const v2u*)(PP + (size_t)m * D) + lane;
        f32x4 e[4]; float s = 0.f;
#pragma unroll
        for (int j = 0; j < 4; ++j) { const f32x4 f = fr[64 * j]; const v2u pw = pr[64 * j];
            const f32x4 pv = {__builtin_bit_cast(float, pw.x << 16), __builtin_bit_cast(float, pw.x & 0xffff0000u), __builtin_bit_cast(float, pw.y << 16), __builtin_bit_cast(float, pw.y & 0xffff0000u)};
            e[j].x = pv.x / (1.0f + expf(-f.x)); e[j].y = pv.y / (1.0f + expf(-f.y)); e[j].z = pv.z / (1.0f + expf(-f.z)); e[j].w = pv.w / (1.0f + expf(-f.w));
            s += (e[j].x * e[j].x + e[j].y * e[j].y) + (e[j].z * e[j].z + e[j].w * e[j].w); }
        const float r = 1.0f / sqrtf(wave_sum(s) * (1.f / D) + EPS);
        const f32x4* hr = (const f32x4*)(h + (size_t)m * D) + lane; f32x4* orow = (f32x4*)(out + (size_t)m * D) + lane;
#pragma unroll
        for (int j = 0; j < 4; ++j) { const f32x4 g4 = ((const f32x4*)g)[lane + 64 * j]; orow[64 * j] = hr[64 * j] + e[j] * g4 * r; }
    }
}


namespace att {
typedef short bf16x8 __attribute__((ext_vector_type(8)));
typedef short s16x4 __attribute__((ext_vector_type(4)));
typedef float f32x16 __attribute__((ext_vector_type(16)));
typedef float f32x2_t __attribute__((ext_vector_type(2)));
typedef __bf16 bf16x2_t __attribute__((ext_vector_type(2)));
constexpr int QKP = 2048;
constexpr float STOP2 = -160.0f;
constexpr float LOG2E = 1.4426950408889634f;
constexpr int XT_L = 0, XT_TB = 2048, TB_STRIDE = 1280;
__device__ __forceinline__ int crow(int r, int hi) { return (r & 3) + 8 * (r >> 2) + 4 * hi; }
__device__ __forceinline__ unsigned cvtpk(float lo, float hi) { f32x2_t v = {lo, hi}; bf16x2_t b = __builtin_convertvector(v, bf16x2_t); return __builtin_bit_cast(unsigned, b); }
__device__ __forceinline__ float swapmax(float v) { auto rr = __builtin_amdgcn_permlane32_swap(__float_as_uint(v), __float_as_uint(v), false, false); return fmaxf(__uint_as_float(rr[0]), __uint_as_float(rr[1])); }
__device__ __forceinline__ float swapsum(float v) { auto rr = __builtin_amdgcn_permlane32_swap(__float_as_uint(v), __float_as_uint(v), false, false); return __uint_as_float(rr[0]) + __uint_as_float(rr[1]); }
#define ATT_SB() __builtin_amdgcn_sched_barrier(0)

__device__ __forceinline__ void load_k(bf16x8 (&kf)[2][4], const unsigned char* Kb, unsigned koff, int kt) {
    const unsigned char* p = Kb + (size_t)kt * (64 * QKP * 2);
#pragma unroll
    for (int kvb = 0; kvb < 2; ++kvb)
#pragma unroll
        for (int s = 0; s < 4; ++s) kf[kvb][s] = *(const bf16x8*)(p + kvb * (32 * QKP * 2) + koff + 32 * s);
}
__device__ __forceinline__ void load_v(bf16x8 (&vf)[2][2][2], const unsigned char* Vb, unsigned voff, int kt) {
    const unsigned char* p = Vb + (size_t)kt * 128;
#pragma unroll
    for (int db = 0; db < 2; ++db)
#pragma unroll
        for (int kvb = 0; kvb < 2; ++kvb)
#pragma unroll
            for (int ks = 0; ks < 2; ++ks) { const unsigned char* q = p + db * (32 * M * 2) + voff + 64 * kvb + 32 * ks;
                const s16x4 lo = *(const s16x4*)q, hh = *(const s16x4*)(q + 16);
                vf[db][kvb][ks] = (bf16x8){lo[0], lo[1], lo[2], lo[3], hh[0], hh[1], hh[2], hh[3]}; }
}
__device__ __forceinline__ f32x16 qk_block(const bf16x8 (&kf)[4], const bf16x8 (&qf)[4], float c0) {
    f32x16 S;
#pragma unroll
    for (int r = 0; r < 16; ++r) S[r] = c0;
#pragma unroll
    for (int s = 0; s < 4; ++s) S = __builtin_amdgcn_mfma_f32_32x32x16_bf16(kf[s], qf[s], S, 0, 0, 0);
    return S;
}
__device__ __forceinline__ void pack_p(const f32x16& P, bf16x8& p0, bf16x8& p1) {
    typedef unsigned u32x4 __attribute__((ext_vector_type(4)));
    u32x4 a, b; a.x = cvtpk(P[0], P[1]); a.y = cvtpk(P[2], P[3]); a.z = cvtpk(P[4], P[5]); a.w = cvtpk(P[6], P[7]);
    b.x = cvtpk(P[8], P[9]); b.y = cvtpk(P[10], P[11]); b.z = cvtpk(P[12], P[13]); b.w = cvtpk(P[14], P[15]);
    p0 = __builtin_bit_cast(bf16x8, a); p1 = __builtin_bit_cast(bf16x8, b);
}
template <bool DIAG> __device__ __forceinline__ void sb_block(f32x16& z, float& C, int r32, int hi) {
    float sp[16];
#pragma unroll
    for (int r = 0; r < 16; ++r) {
        float zz = z[r];
        if (DIAG) zz = (crow(r, hi) < r32) ? zz : -1.0e30f;
        const float e = __builtin_amdgcn_exp2f(-__builtin_fabsf(zz));
        const float l = __builtin_amdgcn_logf(1.0f + e);
        sp[r] = fmaxf(zz, 0.f) + l;
        z[r] = zz - sp[r];
    }
    float gs[4], glo[4], ghi[4];
#pragma unroll
    for (int g = 0; g < 4; ++g) gs[g] = (sp[4 * g] + sp[4 * g + 1]) + (sp[4 * g + 2] + sp[4 * g + 3]);
#pragma unroll
    for (int g = 0; g < 4; ++g) { auto rr = __builtin_amdgcn_permlane32_swap(__float_as_uint(gs[g]), __float_as_uint(gs[g]), false, false); glo[g] = __uint_as_float(rr[0]); ghi[g] = __uint_as_float(rr[1]); }
    float P[4]; P[3] = C; P[2] = P[3] + (glo[3] + ghi[3]); P[1] = P[2] + (glo[2] + ghi[2]); P[0] = P[1] + (glo[1] + ghi[1]); C = P[0] + (glo[0] + ghi[0]);
#pragma unroll
    for (int g = 0; g < 4; ++g) { float acc = P[g] + (hi ? 0.f : ghi[g]);
#pragma unroll
        for (int j = 3; j >= 0; --j) { const float lb = z[4 * g + j]; z[4 * g + j] = __builtin_amdgcn_exp2f(lb - acc); acc += sp[4 * g + j]; } }
}
__device__ __forceinline__ void add_bias(f32x16& S, const LAS float* tbl) {
#pragma unroll
    for (int r = 0; r < 16; ++r) S[r] += tbl[27 - ((r & 3) + 8 * (r >> 2))];
}
__device__ __forceinline__ float max16(const f32x16& S) {
    const float a = fmaxf(fmaxf(S[0], S[1]), fmaxf(S[2], S[3])), b = fmaxf(fmaxf(S[4], S[5]), fmaxf(S[6], S[7]));
    const float c = fmaxf(fmaxf(S[8], S[9]), fmaxf(S[10], S[11])), d = fmaxf(fmaxf(S[12], S[13]), fmaxf(S[14], S[15]));
    return fmaxf(fmaxf(a, b), fmaxf(c, d));
}
__device__ __forceinline__ float sum16(const f32x16& S) {
    return (((S[0] + S[1]) + (S[2] + S[3])) + ((S[4] + S[5]) + (S[6] + S[7]))) + (((S[8] + S[9]) + (S[10] + S[11])) + ((S[12] + S[13]) + (S[14] + S[15])));
}
__device__ __forceinline__ void pv_qb(f32x16 (&o)[2], const bf16x8 (&pa)[2][2], const bf16x8 (&vf)[2][2][2]) {
#pragma unroll
    for (int kvb = 0; kvb < 2; ++kvb)
#pragma unroll
        for (int ks = 0; ks < 2; ++ks)
#pragma unroll
            for (int db = 0; db < 2; ++db) o[db] = __builtin_amdgcn_mfma_f32_32x32x16_bf16(pa[kvb][ks], vf[db][kvb][ks], o[db], 0, 0, 0);
}
template <int QB> __device__ __forceinline__ void sb_pass(f32x16 (&o)[2], const unsigned char* Qb, const unsigned char* Kb, const unsigned char* Vb, unsigned koff, unsigned voff, int i, int r32, int hi) {
    bf16x8 qf[4], kf[2][4], vf[2][2][2], pa[2][2];
#pragma unroll
    for (int s = 0; s < 4; ++s) qf[s] = *(const bf16x8*)(Qb + QB * (32 * QKP * 2) + koff + 32 * s);
    float C = 0.f;
    load_k(kf, Kb, koff, i);
    for (int kt = i; kt >= 0; --kt) {
        const bool diag = (kt == i);
        load_v(vf, Vb, voff, kt);
        ATT_SB();
        f32x16 S1 = qk_block(kf[1], qf, 0.f);
        if (diag) { if (QB == 0) {
#pragma unroll
                for (int r = 0; r < 16; ++r) S1[r] = 0.f;
            } else sb_block<true>(S1, C, r32, hi); }
        else sb_block<false>(S1, C, r32, hi);
        pack_p(S1, pa[1][0], pa[1][1]);
        ATT_SB();
        f32x16 S0 = qk_block(kf[0], qf, 0.f);
        if (diag && QB == 0) sb_block<true>(S0, C, r32, hi); else sb_block<false>(S0, C, r32, hi);
        pack_p(S0, pa[0][0], pa[0][1]);
        ATT_SB();
        if (kt > 0) load_k(kf, Kb, koff, kt - 1);
        ATT_SB();
        pv_qb(o, pa, vf);
        ATT_SB();
        if (__all(C > -STOP2)) break;
    }
}

__device__ __forceinline__ void store_o(LAS float* ot, int qb, const f32x16 (&o)[2], int r32, int hi) {
#pragma unroll
    for (int db = 0; db < 2; ++db)
#pragma unroll
        for (int r = 0; r < 16; ++r) ot[(32 * qb + crow(r, hi)) * 64 + 32 * db + r32] = o[db][r];
}
template <int QB> __device__ __forceinline__ void band_pass(f32x16 (&o)[2], const unsigned char* Qb, const unsigned char* Kb, const unsigned char* Vb, unsigned koff, unsigned voff, int i,
                                                            const LAS float* tl, float cb, LAS float* lx, int r32, int hi) {
    bf16x8 qf[4], kf[2][4], vf[2][2][2], pa[2][2];
#pragma unroll
    for (int s = 0; s < 4; ++s) qf[s] = *(const bf16x8*)(Qb + QB * (32 * QKP * 2) + koff + 32 * s);
    const int c0 = i >= 8 ? i - 8 : 0;
    float mx = -3.0e38f;
    load_k(kf, Kb, koff, c0);
    for (int kt = c0; kt <= i; ++kt) {
        const int w = i - kt;
#pragma unroll
        for (int kvb = 0; kvb < 2; ++kvb) { f32x16 S = qk_block(kf[kvb], qf, w >= 3 ? cb : 0.f); if (w < 3) add_bias(S, tl + 64 * w + 32 * (QB - kvb)); mx = fmaxf(mx, max16(S)); ATT_SB(); }
        if (kt < i) load_k(kf, Kb, koff, kt + 1);
        ATT_SB();
    }
    mx = swapmax(mx);
    float l = 0.f;
    load_k(kf, Kb, koff, c0);
    for (int kt = c0; kt <= i; ++kt) {
        const int w = i - kt;
        load_v(vf, Vb, voff, kt);
        ATT_SB();
#pragma unroll
        for (int kvb = 0; kvb < 2; ++kvb) { f32x16 S = qk_block(kf[kvb], qf, (w >= 3 ? cb : 0.f) - mx); if (w < 3) add_bias(S, tl + 64 * w + 32 * (QB - kvb));
#pragma unroll
            for (int r = 0; r < 16; ++r) S[r] = __builtin_amdgcn_exp2f(S[r]);
            l += sum16(S); pack_p(S, pa[kvb][0], pa[kvb][1]); ATT_SB(); }
        if (kt < i) { load_k(kf, Kb, koff, kt + 1); ATT_SB(); }
        pv_qb(o, pa, vf);
        ATT_SB();
    }
    l = swapsum(l);
    if (hi == 0) lx[r32] = 1.0f / l;
    asm volatile("s_waitcnt lgkmcnt(0)" ::: "memory");
#pragma unroll
    for (int r = 0; r < 16; ++r) { const float li = lx[crow(r, hi)]; o[0][r] *= li; o[1][r] *= li; }
    asm volatile("s_waitcnt lgkmcnt(0)" ::: "memory");
}
template <bool IS_B> __device__ __forceinline__ void att_unit(int b, int i, const bf16* QK, const bf16* VT, const float* relb, const float* gain, bf16* O,
                                                              LAS unsigned char* ring, LAS unsigned char* xtra, int wave, int lane) {
    asm volatile("" : "+v"(lane));
    const int r32 = lane & 31, hi = lane >> 5, head = wave;
    const unsigned char* Qb = (const unsigned char*)(QK + (size_t)(b * SEQ + 64 * i) * QKP + (IS_B ? 1024 : 0) + head * HD);
    const unsigned char* Kb = (const unsigned char*)(QK + (size_t)(b * SEQ) * QKP + (IS_B ? 1536 : 512) + head * HD);
    const unsigned char* Vb = (const unsigned char*)(VT + (size_t)((IS_B ? 512 : 0) + head * HD) * M + b * SEQ);
    const unsigned koff = (unsigned)(r32 * QKP + hi * 8) * 2u, voff = (unsigned)(r32 * M + 4 * hi) * 2u;
    LAS float* ot = (LAS float*)(ring + wave * 16384);
    f32x16 o[2];
    if constexpr (!IS_B) {
#pragma unroll
        for (int db = 0; db < 2; ++db)
#pragma unroll
            for (int r = 0; r < 16; ++r) o[db][r] = 0.f;
        sb_pass<0>(o, Qb, Kb, Vb, koff, voff, i, r32, hi);
        store_o(ot, 0, o, r32, hi);
        ATT_SB();
#pragma unroll
        for (int db = 0; db < 2; ++db)
#pragma unroll
            for (int r = 0; r < 16; ++r) o[db][r] = 0.f;
        sb_pass<1>(o, Qb, Kb, Vb, koff, voff, i, r32, hi);
        store_o(ot, 1, o, r32, hi);
    } else {
        LAS float* tb = (LAS float*)(xtra + XT_TB + wave * TB_STRIDE);
        for (int j = lane; j < 320; j += 64) tb[j] = relb[head * 257 + (j < 256 ? j : 256)] * LOG2E;
        const float cb = relb[head * 257 + 256] * LOG2E;
        asm volatile("s_waitcnt lgkmcnt(0)" ::: "memory");
        const LAS float* tl = tb + r32 - 4 * hi + 101;
        LAS float* lx = (LAS float*)(xtra + XT_L + wave * 256);
#pragma unroll
        for (int db = 0; db < 2; ++db)
#pragma unroll
            for (int r = 0; r < 16; ++r) o[db][r] = 0.f;
        band_pass<0>(o, Qb, Kb, Vb, koff, voff, i, tl, cb, lx, r32, hi);
        store_o(ot, 0, o, r32, hi);
        ATT_SB();
#pragma unroll
        for (int db = 0; db < 2; ++db)
#pragma unroll
            for (int r = 0; r < 16; ++r) o[db][r] = 0.f;
        band_pass<1>(o, Qb, Kb, Vb, koff, voff, i, tl, cb, lx, r32, hi);
        store_o(ot, 1, o, r32, hi);
    }
    asm volatile("s_waitcnt lgkmcnt(0)" ::: "memory"); __builtin_amdgcn_s_barrier(); asm volatile("" ::: "memory");
    const f32x4 g0 = ((const f32x4*)gain)[2 * lane], g1 = ((const f32x4*)gain)[2 * lane + 1];
    const LAS unsigned char* src = ring + (lane >> 3) * 16384 + (lane & 7) * 32;
#pragma unroll
    for (int j = 0; j < 8; ++j) { const int q = 8 * wave + j;
        const f32x4 a = *(const LAS f32x4*)(src + q * 256), c = *(const LAS f32x4*)(src + q * 256 + 16);
        float ss = ((a.x * a.x + a.y * a.y) + (a.z * a.z + a.w * a.w)) + ((c.x * c.x + c.y * c.y) + (c.z * c.z + c.w * c.w));
        ss = wave_sum(ss); const float rs = 1.0f / sqrtf(ss * (1.0f / 512.0f) + EPS);
        v4u w; w.x = pk2(a.x * rs * g0.x, a.y * rs * g0.y); w.y = pk2(a.z * rs * g0.z, a.w * rs * g0.w); w.z = pk2(c.x * rs * g1.x, c.y * rs * g1.y); w.w = pk2(c.z * rs * g1.z, c.w * rs * g1.w);
        *(v4u*)(O + (size_t)(b * SEQ + 64 * i + q) * D + (IS_B ? 512 : 0) + 8 * lane) = w; }
    asm volatile("s_waitcnt lgkmcnt(0)" ::: "memory"); __builtin_amdgcn_s_barrier(); asm volatile("" ::: "memory");
}
#undef ATT_SB
}

__global__ void __launch_bounds__(NWAVES * 64, 2) fwd_megakernel(Args args) {
    extern __shared__ __attribute__((aligned(16))) unsigned char lds[];
    Ctx c; c.lds = (LAS unsigned char*)lds; c.tid = threadIdx.x; c.lane = c.tid & 63; c.wave = __builtin_amdgcn_readfirstlane(c.tid >> 6);
    const int G = gridDim.x, bx = blockIdx.x; const int vcu = (G % 8 == 0) ? (bx % 8) * (G / 8) + bx / 8 : bx;
    c.gw = vcu * NWAVES + c.wave; c.NGW = G * NWAVES;
    volatile LAS unsigned* MISC = (volatile LAS unsigned*)(c.lds + MISC_OFF);
    unsigned char* ws = args.ws; const float* const* in = args.in; float* out = args.out;
    for (int u = c.tid; u < (LDS_BYTES - LDSCTL_OFF) / 4; u += NWAVES * 64) ((LAS unsigned*)(c.lds + LDSCTL_OFF))[u] = 0u;
    __syncthreads();
    XcdBarrier bar = xcd_barrier_post((unsigned*)(ws + WS_CTL) + CW_BAR, MISC + 8);
    bf16* XN = (bf16*)(ws + WS_XN); bf16* BIG = (bf16*)(ws + WS_BIG); float* F = (float*)(ws + WS_F); bf16* Pb = (bf16*)(ws + WS_P);
    LAS unsigned char* ring = c.lds + RING_OFF;
#define GRID_BAR() xcd_barrier(bar)
#define GEMM(EPI, OUTT, Aptr, Bptr, outp, M_, N_, K_, ld_) do { pg8::Gemm g{Aptr, Bptr, M_, N_, K_}; pg8::StaticOrder S; S.init(M_, N_, G, bx); pg8::EPI E{(OUTT*)(outp), ld_}; \
        pg8::gemm_phase<pg8::EPI, pg8::StaticOrder, true, true>(ring, g, S, E); } while (0)
    bf16* QK = BIG; bf16* VT = (bf16*)(ws + WS_VT);

    p_prologue(args, c); GRID_BAR();
    GEMM(EpiSwiGLU, bf16, XN, (const bf16*)(ws + WS_W1GU), BIG, M, 2 * FF, D, FF); GRID_BAR();
    GEMM(EpiF32, float, BIG, (const bf16*)(ws + WS_W1D), F, M, D, FF, D); GRID_BAR();
    p_post(c, F, in[0], out, in[3], in[7], XN, 0.5f, 1); GRID_BAR();
    GEMM(EpiBf16, bf16, XN, (const bf16*)(ws + WS_WQK), QK, M, 2048, D, 2048);
    GEMM(EpiBf16, bf16, (const bf16*)(ws + WS_WV), XN, VT, D, M, D, M); GRID_BAR();
    { const int b = vcu >> 5, i = vcu & 31;
      for (int u = vcu; u < BATCH * 32; u += G) { att::att_unit<false>(u >> 5, u & 31, QK, VT, in[12], in[10], XN, ring, c.lds + XTRA_OFF, c.wave, c.lane);
                                                  att::att_unit<true>(u >> 5, u & 31, QK, VT, in[12], in[11], XN, ring, c.lds + XTRA_OFF, c.wave, c.lane); }
      (void)b; (void)i; }
    GRID_BAR();
    GEMM(EpiF32, float, XN, (const bf16*)(ws + WS_WOUT), F, M, D, D, D); GRID_BAR();
    p_post(c, F, out, out, in[8], in[14], XN, 1.0f, 1); GRID_BAR();
    GEMM(EpiSwiGLU, bf16, XN, (const bf16*)(ws + WS_W2GU), BIG, M, 2 * FF, D, FF); GRID_BAR();
    GEMM(EpiF32, float, BIG, (const bf16*)(ws + WS_W2D), F, M, D, FF, D); GRID_BAR();
    p_post(c, F, out, out, in[15], in[15], XN, 0.5f, 2); GRID_BAR();
    GEMM(EpiBf16, bf16, Pb, (const bf16*)(ws + WS_WP), BIG, M, D, PLE, D);
    GEMM(EpiF32, float, XN, (const bf16*)(ws + WS_WG), F, M, D, D, D); GRID_BAR();
    p_final(c, F, BIG, out, in[21], out);
}

extern "C" void kernel_launch(void* const* d_in, const int* in_sizes, int n_in, void* d_out, int out_size, void* d_ws, size_t ws_size, hipStream_t stream) {
    static int grid = 0;
    if (grid == 0) {
        if (n_in != 22 || in_sizes[0] != M * D || out_size != M * D || ws_size < WS_END) { fprintf(stderr, "kernel_launch: unexpected shapes n_in %d in0 %d out %d ws %zu\n", n_in, n_in > 0 ? in_sizes[0] : -1, out_size, ws_size); grid = -1; return; }
        int dev = 0, cus = 0, per_cu = 0;
        if (hipGetDevice(&dev) != hipSuccess || hipDeviceGetAttribute(&cus, hipDeviceAttributeMultiprocessorCount, dev) != hipSuccess) { fprintf(stderr, "kernel_launch: device query failed\n"); grid = -1; return; }
        if (hipFuncSetAttribute((const void*)fwd_megakernel, hipFuncAttributeMaxDynamicSharedMemorySize, LDS_BYTES) != hipSuccess) { fprintf(stderr, "kernel_launch: hipFuncSetAttribute failed\n"); grid = -1; return; }
        if (hipOccupancyMaxActiveBlocksPerMultiprocessor(&per_cu, (const void*)fwd_megakernel, NWAVES * 64, LDS_BYTES) != hipSuccess || per_cu < 1) { fprintf(stderr, "kernel_launch: occupancy query says %d blocks per CU\n", per_cu); (void)hipGetLastError(); grid = -1; return; }
        grid = cus;
        if (grid != 256) fprintf(stderr, "kernel_launch: note: %d CUs\n", grid);
    }
    if (grid < 0) return;
    if (hipMemsetAsync((char*)d_ws + WS_CTL, 0, CTL_ZERO_BYTES, stream) != hipSuccess) { fprintf(stderr, "kernel_launch: memset failed\n"); return; }
    Args a{}; for (int i = 0; i < 22; ++i) a.in[i] = (const float*)d_in[i]; a.out = (float*)d_out; a.ws = (unsigned char*)d_ws;
    void* kargs[] = {&a};
    const hipError_t e = hipLaunchCooperativeKernel((const void*)fwd_megakernel, dim3(grid), dim3(NWAVES * 64), kargs, LDS_BYTES, stream);
    if (e != hipSuccess) fprintf(stderr, "kernel_launch: cooperative launch failed: %s (grid %d)\n", hipGetErrorString(e), grid);
}
```
